# Optimizing an MI355X kernel written in HIP

```python
import math
import jax, jax.numpy as jnp
from jax import lax
import numpy as np

D_MODEL = 1024
BATCH = 2
SEQ = 8192
DEPTH = 2

N_EVEN = (DEPTH + 1) // 2
N_ODD = DEPTH // 2
GROUP_WIDTH = D_MODEL // 2

RET_HEADS = 4
RET_HEAD_DIM = GROUP_WIDTH // RET_HEADS
RET_W = RET_HEADS * RET_HEAD_DIM
RET_THETA = 10000.0
DIFF_HEADS = 4
DIFF_HEAD_DIM = GROUP_WIDTH // (2 * DIFF_HEADS)
DIFF_V_DIM = 2 * DIFF_HEAD_DIM
DIFF_QK_W = 2 * DIFF_HEADS * DIFF_HEAD_DIM
DIFF_V_W = DIFF_HEADS * DIFF_V_DIM
ROPE_THETA = 500000.0
DIFF_ROT_DIM = DIFF_HEAD_DIM // 4
MLA_HEADS = 4
MLA_Q_RANK = 256
MLA_KV_RANK = 128
MLA_NOPE = 64
MLA_ROPE = 32
MLA_V = GROUP_WIDTH // MLA_HEADS
GLA_HEADS = 4
GLA_K_DIM = GROUP_WIDTH // 2 // GLA_HEADS
GLA_V_DIM = GROUP_WIDTH // GLA_HEADS
GLA_K_W = GLA_HEADS * GLA_K_DIM
GLA_V_W = GLA_HEADS * GLA_V_DIM
GLA_GATE_RANK = 16
GLA_TAU = 16.0
CHUNK = 64
Q_BLOCK = 128
N_GROUPS = 4
EXPERTS_PER_GROUP = 8
N_EXPERTS = N_GROUPS * EXPERTS_PER_GROUP
TOP_K_IN_GROUP = 2
D_EXPERT = 512
MOE_BLOCK = 128
ALPHA = (2.0 * DEPTH) ** 0.25
BETA = (8.0 * DEPTH) ** -0.25
LN_EPS = 1e-5

EVEN_SPLITS = (RET_W, RET_W, RET_W, RET_W, DIFF_QK_W, DIFF_QK_W, DIFF_V_W)
EVEN_VALUE_BLOCKS = (2, 6)
EVEN_IN = sum(EVEN_SPLITS)
ODD_SPLITS = (MLA_Q_RANK, MLA_KV_RANK, MLA_ROPE, GLA_K_W, GLA_K_W, GLA_V_W, GLA_V_W, GLA_GATE_RANK, GLA_GATE_RANK)
ODD_VALUE_BLOCKS = (5,)
ODD_IN = sum(ODD_SPLITS)

kernel_name = 'hybrid_retnet_diffattn_mla_gla_hmoe_encoder'

F32 = jnp.float32


def _split(z, sizes):
    return jnp.split(z, np.cumsum(sizes)[:-1].tolist(), axis=-1)


def _heads(z, h):
    b, t, _ = z.shape
    return z.reshape(b, t, h, -1).transpose(0, 2, 1, 3)


def _merge(z):
    b, h, t, d = z.shape
    return z.transpose(0, 2, 1, 3).reshape(b, t, h * d)


def _layer_norm(x, g, b):
    xf = x.astype(F32)
    mu = jnp.mean(xf, -1, keepdims=True)
    var = jnp.mean(jnp.square(xf - mu), -1, keepdims=True)
    return ((xf - mu) * lax.rsqrt(var + LN_EPS) * g + b).astype(x.dtype)


def _group_norm(z):
    zf = z.astype(F32)
    mu = jnp.mean(zf, -1, keepdims=True)
    var = jnp.mean(jnp.square(zf - mu), -1, keepdims=True)
    return ((zf - mu) * lax.rsqrt(var + LN_EPS)).astype(z.dtype)


def _rms_norm(z, g):
    zf = z.astype(F32)
    return (zf * lax.rsqrt(jnp.mean(jnp.square(zf), -1, keepdims=True) + 1e-6) * g).astype(z.dtype)


def _rotary(x, rot_dim, theta):
    t = x.shape[2]
    half = rot_dim // 2
    pos = jnp.arange(t, dtype=F32)
    inv = jnp.power(jnp.float32(theta), -jnp.arange(0, rot_dim, 2, dtype=F32) / rot_dim)
    ang = pos[:, None] * inv[None, :]
    cos, sin = jnp.cos(ang), jnp.sin(ang)
    xr = x[..., :rot_dim].astype(F32)
    x1, x2 = xr[..., :half], xr[..., half:]
    rot = jnp.concatenate([x1 * cos - x2 * sin, x2 * cos + x1 * sin], -1).astype(x.dtype)
    return jnp.concatenate([rot, x[..., rot_dim:]], -1)


def _chunk_scan(q, k, v, log_a, strict):
    b, h, t, dk = q.shape
    dv = v.shape[-1]
    n = t // CHUNK

    def chunks(z):
        return z.reshape(b, h, n, CHUNK, z.shape[-1]).transpose(2, 0, 1, 3, 4)

    cum = jnp.cumsum(chunks(log_a.astype(F32)), axis=3)
    mask = jnp.tril(jnp.ones((CHUNK, CHUNK), bool), -1 if strict else 0)[None, None, :, :, None]

    def step(state, inp):
        qi, ki, vi, bi = inp
        qi, ki, vi = qi.astype(F32), ki.astype(F32), vi.astype(F32)
        o_inter = jnp.einsum('bhck,bhkv->bhcv', qi * jnp.exp(bi), state)
        diff = bi[:, :, :, None, :] - bi[:, :, None, :, :]
        decay = jnp.where(mask, jnp.exp(jnp.where(mask, diff, 0.0)), 0.0)
        scores = jnp.sum(qi[:, :, :, None, :] * ki[:, :, None, :, :] * decay, axis=-1)
        o_intra = jnp.einsum('bhij,bhjv->bhiv', scores, vi)
        b_last = bi[:, :, -1:, :]
        state = jnp.exp(b_last[:, :, 0, :, None]) * state + jnp.einsum('bhck,bhcv->bhkv', ki * jnp.exp(b_last - bi), vi)
        return state, o_inter + o_intra

    state0 = jnp.zeros((b, h, dk, dv), F32)
    _, o = lax.scan(step, state0, (chunks(q), chunks(k), chunks(v), cum))
    return o.transpose(1, 2, 0, 3, 4).reshape(b, h, t, dv).astype(v.dtype)


def _bidirectional_scan(q, k, v, log_a_fwd, log_a_bwd):
    rev = lambda z: jnp.flip(z, axis=2)
    fwd = _chunk_scan(q, k, v, log_a_fwd, strict=False)
    bwd = rev(_chunk_scan(rev(q), rev(k), rev(v), rev(log_a_bwd), strict=True))
    return fwd + bwd


def _query_blocks(z):
    b, h, t, d = z.shape
    return z.reshape(b, h, t // Q_BLOCK, Q_BLOCK, d).transpose(2, 0, 1, 3, 4)


def _unblock(o):
    nb, b, h, qb, d = o.shape
    return o.transpose(1, 2, 0, 3, 4).reshape(b, h, nb * qb, d)


def _blocked_attention(q, k, v, scale):
    def one(qi):
        s = jnp.einsum('bhqd,bhkd->bhqk', qi, k).astype(F32) * scale
        p = jax.nn.softmax(s, axis=-1)
        return jnp.einsum('bhqk,bhkd->bhqd', p.astype(v.dtype), v)
    return _unblock(lax.map(one, _query_blocks(q)))


def _blocked_diff_attention(q1, q2, k1, k2, v, lam, scale):
    def one(qs):
        qa, qb = qs
        p1 = jax.nn.softmax(jnp.einsum('bhqd,bhkd->bhqk', qa, k1).astype(F32) * scale, axis=-1)
        p2 = jax.nn.softmax(jnp.einsum('bhqd,bhkd->bhqk', qb, k2).astype(F32) * scale, axis=-1)
        return jnp.einsum('bhqk,bhkd->bhqd', (p1 - lam * p2).astype(v.dtype), v)
    return _unblock(lax.map(one, (_query_blocks(q1), _query_blocks(q2))))


def _retention_diff_mixer(x, w_in, ret_decay_f, ret_decay_b, lq1, lk1, lq2, lk2, subln, w_out, layer_idx):
    rq, rk, rv, rg, dq, dk, dv = _split(x @ w_in, EVEN_SPLITS)
    b, t, _ = x.shape
    q = _rotary(_heads(rq, RET_HEADS), RET_HEAD_DIM, RET_THETA)
    k = _rotary(_heads(rk, RET_HEADS), RET_HEAD_DIM, RET_THETA) * (RET_HEAD_DIM ** -0.5)
    v = _heads(rv, RET_HEADS)
    la_f = jnp.broadcast_to((-jnp.exp(ret_decay_f.astype(F32)))[None, :, None, None], (b, RET_HEADS, t, 1))
    la_b = jnp.broadcast_to((-jnp.exp(ret_decay_b.astype(F32)))[None, :, None, None], (b, RET_HEADS, t, 1))
    ret = _merge(_group_norm(_bidirectional_scan(q, k, v, la_f, la_b))) * jax.nn.silu(rg)
    def pair(z):
        z = z.reshape(b, t, DIFF_HEADS, 2, DIFF_HEAD_DIM).transpose(0, 2, 3, 1, 4)
        return (_rotary(z[:, :, 0], DIFF_ROT_DIM, ROPE_THETA), _rotary(z[:, :, 1], DIFF_ROT_DIM, ROPE_THETA))
    q1, q2 = pair(dq)
    k1, k2 = pair(dk)
    vv = _heads(dv, DIFF_HEADS)
    lam_init = 0.8 - 0.6 * math.exp(-0.3 * layer_idx)
    lam = (jnp.exp(jnp.sum(lq1 * lk1)) - jnp.exp(jnp.sum(lq2 * lk2))).astype(F32) + lam_init
    o = _blocked_diff_attention(q1, q2, k1, k2, vv, lam, DIFF_HEAD_DIM ** -0.5)
    diff = _merge(_rms_norm(o, subln) * (1.0 - lam_init))
    return jnp.concatenate([ret, diff], axis=-1) @ w_out


def _mla_gla_mixer(x, w_in, q_norm, w_uq, kv_norm, w_ukv, gla_w2_f, gla_b_f, gla_w2_b, gla_b_b, gla_norm, w_out):
    cq, ckv, krope, gq, gk, gv, gg, lr_f, lr_b = _split(x @ w_in, ODD_SPLITS)
    qh = _heads(_rms_norm(cq, q_norm) @ w_uq, MLA_HEADS)
    q = jnp.concatenate([qh[..., :MLA_NOPE], _rotary(qh[..., MLA_NOPE:], MLA_ROPE, ROPE_THETA)], -1)
    kvh = _heads(_rms_norm(ckv, kv_norm) @ w_ukv, MLA_HEADS)
    k_nope, v = kvh[..., :MLA_NOPE], kvh[..., MLA_NOPE:]
    k_rope = _rotary(krope[:, None], MLA_ROPE, ROPE_THETA)
    k = jnp.concatenate([k_nope, jnp.broadcast_to(k_rope, k_nope.shape[:-1] + (MLA_ROPE,))], -1)
    mla = _merge(_blocked_attention(q, k, v, (MLA_NOPE + MLA_ROPE) ** -0.5))
    def log_gate(lr, w2, bias):
        return _heads(jax.nn.log_sigmoid((lr @ w2 + bias).astype(F32)) / GLA_TAU, GLA_HEADS)
    gq_h = _heads(gq, GLA_HEADS) * (GLA_K_DIM ** -0.5)
    o = _bidirectional_scan(gq_h, _heads(gk, GLA_HEADS), _heads(gv, GLA_HEADS), log_gate(lr_f, gla_w2_f, gla_b_f), log_gate(lr_b, gla_w2_b, gla_b_b))
    gla = _merge(_rms_norm(o, gla_norm)) * jax.nn.silu(gg)
    return jnp.concatenate([mla, gla], axis=-1) @ w_out


def _hier_moe(x, w_grp, b_grp, w_exp, b_exp, w_gate, w_up, w_down):
    b, t, d = x.shape
    n = b * t
    xf = x.reshape(n, d)
    grp_logits = (xf @ w_grp + b_grp).astype(F32)
    g_idx = jnp.argmax(grp_logits, axis=-1).astype(jnp.int32)
    p_grp = jnp.take_along_axis(jax.nn.softmax(grp_logits, -1), g_idx[:, None], axis=1)[:, 0]
    exp_logits = (xf @ w_exp + b_exp).astype(F32).reshape(n, N_GROUPS, EXPERTS_PER_GROUP)
    in_grp = jnp.take_along_axis(exp_logits, g_idx[:, None, None], axis=1)[:, 0]
    top_l, top_e = lax.top_k(in_grp, TOP_K_IN_GROUP)
    gate = p_grp[:, None] * jax.nn.softmax(top_l, axis=-1)
    eid = (g_idx[:, None] * EXPERTS_PER_GROUP + top_e).reshape(-1).astype(jnp.int32)
    tok = jnp.repeat(jnp.arange(n, dtype=jnp.int32), TOP_K_IN_GROUP)
    gw = gate.reshape(-1)
    a = eid.shape[0]
    order = jnp.argsort(eid)
    eid_s, tok_s, gw_s = eid[order], tok[order], gw[order]
    counts = jnp.bincount(eid, length=N_EXPERTS).astype(jnp.int32)
    padded = (counts + MOE_BLOCK - 1) // MOE_BLOCK * MOE_BLOCK
    start = jnp.cumsum(counts) - counts
    pend = jnp.cumsum(padded)
    pstart = pend - padded
    dest = pstart[eid_s] + (jnp.arange(a, dtype=jnp.int32) - start[eid_s])
    cap = a + N_EXPERTS * MOE_BLOCK
    nb = cap // MOE_BLOCK
    buf_tok = jnp.full((cap,), n, jnp.int32).at[dest].set(tok_s)
    buf_w = jnp.zeros((cap,), F32).at[dest].set(gw_s)
    blk_e = jnp.minimum(jnp.searchsorted(pend, jnp.arange(nb, dtype=jnp.int32) * MOE_BLOCK, side='right'), N_EXPERTS - 1).astype(jnp.int32)
    x_pad = jnp.concatenate([xf, jnp.zeros((1, d), xf.dtype)], axis=0)

    def expert_block(args):
        idx, e = args
        xb = x_pad[idx]
        hdn = jax.nn.silu(xb @ w_gate[e]) * (xb @ w_up[e])
        return hdn @ w_down[e]

    y = lax.map(expert_block, (buf_tok.reshape(nb, MOE_BLOCK), blk_e)).reshape(cap, d)
    out = jnp.zeros((n + 1, d), x.dtype).at[buf_tok].add(y * buf_w[:, None].astype(y.dtype))
    return out[:n].reshape(b, t, d)


def setup_inputs(seed: int = 0) -> dict:
    key = jax.random.key(seed)
    ks = iter(jax.random.split(key, 40))

    def nrm(shape, scale):
        return jax.random.normal(next(ks), shape, jnp.float32) * scale

    def gain(shape):
        return 1.0 + nrm(shape, 0.02)

    ev_col = np.concatenate([np.full((w,), BETA if i in EVEN_VALUE_BLOCKS else 1.0, np.float32) for i, w in enumerate(EVEN_SPLITS)])
    od_col = np.concatenate([np.full((w,), BETA if i in ODD_VALUE_BLOCKS else 1.0, np.float32) for i, w in enumerate(ODD_SPLITS)])
    ukv_col = np.tile(np.concatenate([np.ones((MLA_NOPE,), np.float32), np.full((MLA_V,), BETA, np.float32)]), MLA_HEADS)
    gam = 1.0 - 2.0 ** (-5.0 - np.arange(RET_HEADS))
    ret_base = jnp.asarray(np.log(-np.log(gam)), jnp.float32)
    return {
        'x': nrm((BATCH, SEQ, D_MODEL), 1.0),
        'ev_w_in': nrm((N_EVEN, D_MODEL, EVEN_IN), D_MODEL ** -0.5) * jnp.asarray(ev_col),
        'ev_ret_decay_f': ret_base + nrm((N_EVEN, RET_HEADS), 0.05),
        'ev_ret_decay_b': ret_base + nrm((N_EVEN, RET_HEADS), 0.05),
        'ev_lq1': nrm((N_EVEN, DIFF_HEAD_DIM), 0.1),
        'ev_lk1': nrm((N_EVEN, DIFF_HEAD_DIM), 0.1),
        'ev_lq2': nrm((N_EVEN, DIFF_HEAD_DIM), 0.1),
        'ev_lk2': nrm((N_EVEN, DIFF_HEAD_DIM), 0.1),
        'ev_subln': gain((N_EVEN, DIFF_V_DIM)),
        'ev_w_out': nrm((N_EVEN, D_MODEL, D_MODEL), D_MODEL ** -0.5 * BETA),
        'od_w_in': nrm((N_ODD, D_MODEL, ODD_IN), D_MODEL ** -0.5) * jnp.asarray(od_col),
        'od_q_norm': gain((N_ODD, MLA_Q_RANK)),
        'od_w_uq': nrm((N_ODD, MLA_Q_RANK, MLA_HEADS * (MLA_NOPE + MLA_ROPE)), MLA_Q_RANK ** -0.5),
        'od_kv_norm': gain((N_ODD, MLA_KV_RANK)),
        'od_w_ukv': nrm((N_ODD, MLA_KV_RANK, MLA_HEADS * (MLA_NOPE + MLA_V)), MLA_KV_RANK ** -0.5) * jnp.asarray(ukv_col),
        'od_gla_w2_f': nrm((N_ODD, GLA_GATE_RANK, GLA_K_W), GLA_GATE_RANK ** -0.5),
        'od_gla_b_f': nrm((N_ODD, GLA_K_W), 0.5),
        'od_gla_w2_b': nrm((N_ODD, GLA_GATE_RANK, GLA_K_W), GLA_GATE_RANK ** -0.5),
        'od_gla_b_b': nrm((N_ODD, GLA_K_W), 0.5),
        'od_gla_norm': gain((N_ODD, GLA_V_DIM)),
        'od_w_out': nrm((N_ODD, D_MODEL, D_MODEL), D_MODEL ** -0.5 * BETA),
        'ln1_g': gain((DEPTH, D_MODEL)),
        'ln1_b': nrm((DEPTH, D_MODEL), 0.02),
        'ln2_g': gain((DEPTH, D_MODEL)),
        'ln2_b': nrm((DEPTH, D_MODEL), 0.02),
        'moe_w_grp': nrm((DEPTH, D_MODEL, N_GROUPS), D_MODEL ** -0.5),
        'moe_b_grp': nrm((DEPTH, N_GROUPS), 0.01),
        'moe_w_exp': nrm((DEPTH, D_MODEL, N_EXPERTS), D_MODEL ** -0.5),
        'moe_b_exp': nrm((DEPTH, N_EXPERTS), 0.01),
        'moe_w_gate': nrm((DEPTH, N_EXPERTS, D_MODEL, D_EXPERT), D_MODEL ** -0.5),
        'moe_w_up': nrm((DEPTH, N_EXPERTS, D_MODEL, D_EXPERT), D_MODEL ** -0.5 * BETA),
        'moe_w_down': nrm((DEPTH, N_EXPERTS, D_EXPERT, D_MODEL), D_EXPERT ** -0.5 * BETA),
    }


def reference(x, ev_w_in, ev_ret_decay_f, ev_ret_decay_b, ev_lq1, ev_lk1, ev_lq2, ev_lk2, ev_subln, ev_w_out,
              od_w_in, od_q_norm, od_w_uq, od_kv_norm, od_w_ukv, od_gla_w2_f, od_gla_b_f, od_gla_w2_b, od_gla_b_b, od_gla_norm, od_w_out,
              ln1_g, ln1_b, ln2_g, ln2_b,
              moe_w_grp, moe_b_grp, moe_w_exp, moe_b_exp, moe_w_gate, moe_w_up, moe_w_down):
    for i in range(DEPTH):
        j = i // 2
        if i % 2 == 0:
            mix = _retention_diff_mixer(x, ev_w_in[j], ev_ret_decay_f[j], ev_ret_decay_b[j], ev_lq1[j], ev_lk1[j], ev_lq2[j], ev_lk2[j], ev_subln[j], ev_w_out[j], i)
        else:
            mix = _mla_gla_mixer(x, od_w_in[j], od_q_norm[j], od_w_uq[j], od_kv_norm[j], od_w_ukv[j], od_gla_w2_f[j], od_gla_b_f[j], od_gla_w2_b[j], od_gla_b_b[j], od_gla_norm[j], od_w_out[j])
        x = _layer_norm(ALPHA * x + mix, ln1_g[i], ln1_b[i])
        ffn = _hier_moe(x, moe_w_grp[i], moe_b_grp[i], moe_w_exp[i], moe_b_exp[i], moe_w_gate[i], moe_w_up[i], moe_w_down[i])
        x = _layer_norm(ALPHA * x + ffn, ln2_g[i], ln2_b[i])
    return x
```

```cpp
#include <hip/hip_runtime.h>
#include <cstdio>
#include <cstdint>

#define LAS __attribute__((address_space(3)))
typedef unsigned short bf16_t;
typedef short bf16x8 __attribute__((ext_vector_type(8)));
typedef short s16x4 __attribute__((ext_vector_type(4)));
typedef short v4i16_t __attribute__((ext_vector_type(4)));
typedef float f32x2 __attribute__((ext_vector_type(2)));
typedef float f32x4 __attribute__((ext_vector_type(4)));
typedef float f32x16 __attribute__((ext_vector_type(16)));
typedef unsigned u32x2 __attribute__((ext_vector_type(2)));
typedef int i32x2 __attribute__((ext_vector_type(2)));
typedef unsigned u32x4 __attribute__((ext_vector_type(4)));

constexpr int NTOK = 16384, SEQ = 8192, DM = 1024, NCHUNK = 128;
constexpr int LDZ0 = 3584, LDZ1 = 2048;
constexpr int Z0_RQ = 0, Z0_RK = 512, Z0_RV = 1024, Z0_RG = 1536, Z0_DQ = 2048, Z0_DK = 2560, Z0_DV = 3072;
constexpr int Z1_CQ = 0, Z1_CKV = 256, Z1_KR = 384, Z1_GQ = 416, Z1_GK = 672, Z1_GV = 928, Z1_GG = 1440, Z1_LRF = 1952, Z1_LRB = 1968;
constexpr float ALPHA = 1.4142135623730951f;
constexpr float LN_EPS = 1e-5f;
constexpr int MOE_CAP = 32768 + 32 * 256;
constexpr int MAX_TILES = MOE_CAP / 256;

constexpr size_t MiB = 1u << 20;
constexpr size_t WS_CTL = 0, CTL_ZERO_BYTES = 64 * 1024;
constexpr size_t WS_TAB = 1 * MiB;
constexpr size_t WS_WR = 7 * MiB;
constexpr size_t WS_WUQ = 7 * MiB + 512 * 1024;
constexpr size_t WS_WUKV = 8 * MiB;
constexpr size_t WS_WIN0 = 9 * MiB;
constexpr size_t WS_WOUT0 = 16 * MiB;
constexpr size_t WS_WIN1 = 18 * MiB;
constexpr size_t WS_WOUT1 = 22 * MiB;
constexpr size_t WS_WGU = 24 * MiB;
constexpr size_t WS_WDN = 88 * MiB;
constexpr size_t WS_X1F = 120 * MiB;
constexpr size_t WS_XB = 184 * MiB;
constexpr size_t WS_A2 = 216 * MiB;
constexpr size_t WS_ASG = 248 * MiB;
constexpr size_t WS_ROWINFO = 249 * MiB;
constexpr size_t WS_TILES = 250 * MiB;
constexpr size_t WS_CNTB = 251 * MiB;
constexpr size_t WS_S = 252 * MiB;
constexpr size_t WS_Z = WS_S;
constexpr size_t WS_U = WS_S + 112 * MiB;
constexpr size_t WS_OAB = WS_S + 176 * MiB;
constexpr size_t WS_MQ = WS_S + 64 * MiB;
constexpr size_t WS_MK = WS_S + 80 * MiB;
constexpr size_t WS_MV = WS_S + 96 * MiB;
constexpr size_t WS_AQ = WS_S + 176 * MiB;
constexpr size_t WS_AKV = WS_S + 184 * MiB;
constexpr size_t WS_BF = WS_S + 192 * MiB;
constexpr size_t WS_BB = WS_S + 208 * MiB;
constexpr size_t WS_Y = WS_S;
constexpr size_t WS_XS = WS_S + 64 * MiB;
constexpr size_t WS_H = WS_S + 144 * MiB;
constexpr size_t WS_YS = WS_S + 184 * MiB;
constexpr size_t WS_END = WS_S + 256 * MiB;
constexpr size_t TAB_COSR = 0, TAB_SINR = 8192 * 64, TAB_COSD = 2 * 8192 * 64, TAB_SIND = TAB_COSD + 8192 * 8, TAB_COSM = TAB_SIND + 8192 * 8, TAB_SINM = TAB_COSM + 8192 * 16;
constexpr int CW_BAR = 1024;
constexpr int CW_CNT0 = 8192, CW_CNT1 = 8192 + 64;

typedef __bf16 bf16x2_t __attribute__((ext_vector_type(2)));
__device__ __forceinline__ unsigned cvtpk_asm(float lo, float hi) { unsigned r; asm volatile("v_cvt_pk_bf16_f32 %0, %1, %2" : "=v"(r) : "v"(lo), "v"(hi)); return r; }
__device__ __forceinline__ unsigned cvtpk(float lo, float hi) { f32x2 v = {lo, hi}; bf16x2_t b = __builtin_convertvector(v, bf16x2_t); return __builtin_bit_cast(unsigned, b); }
__device__ __forceinline__ float bflo(unsigned w) { return __uint_as_float(w << 16); }
__device__ __forceinline__ float bfhi(unsigned w) { return __uint_as_float(w & 0xffff0000u); }
__device__ __forceinline__ float bf1(bf16_t b) { return __uint_as_float(((unsigned)b) << 16); }
__device__ __forceinline__ bf16_t f2bf(float f) { return (bf16_t)(cvtpk(f, 0.f) & 0xffffu); }
__device__ __forceinline__ float wave_sum(float v) {
#pragma unroll
    for (int o = 1; o < 64; o <<= 1) v += __shfl_xor(v, o);
    return v;
}
__device__ __forceinline__ float half_sum(float v) {
#pragma unroll
    for (int o = 1; o < 32; o <<= 1) v += __shfl_xor(v, o);
    return v;
}
__device__ __forceinline__ float silu_f(float x) { return x * __builtin_amdgcn_rcpf(1.f + __expf(-x)); }
__device__ __forceinline__ int otid_(int wv) { unsigned l; asm volatile("v_mbcnt_lo_u32_b32 %0, -1, 0\n\tv_mbcnt_hi_u32_b32 %0, -1, %0" : "=v"(l)); return (wv << 6) | (int)l; }
#define otid() otid_(WV_)
#define LDS_WAIT() asm volatile("s_waitcnt lgkmcnt(0)" ::: "memory")
#define VM_WAIT() asm volatile("s_waitcnt vmcnt(0)" ::: "memory")

namespace pg8 {
constexpr int BM = 256, BK = 64, HALF = 128, HTB = HALF * BK * 2, STAGE_BYTES = 8 * HTB, NXCD = 8, WGM = 8;
__host__ __device__ __forceinline__ int lds_byte(int r, int c) { const int st = (r >> 4) * 2 + (c >> 5), rr = r & 15, cc = c & 31, ob = rr * 64 + cc * 2; return st * 1024 + (ob ^ (((ob >> 9) & 1) << 5)); }
__host__ __device__ __forceinline__ void stage_rc(int b, int& R, int& C) { const int st = b / 1024, sb = b % 1024, swz = sb ^ (((sb >> 9) & 1) << 5); R = (st >> 1) * 16 + swz / 64; C = (st & 1) * 32 + (swz % 64) / 2; }
__host__ __device__ __forceinline__ int perm32(int rho) { const int n = rho >> 4, i = rho & 15; return 8 * (i >> 2) + 4 * n + (i & 3); }

struct Unit { int pm, pn, brow; };
struct Gemm { const bf16_t* A; const bf16_t* Bt; int lda, ldb, K; };

struct StaticOrder {
    int nM, nN, nwg, G, c;
    __device__ void init(int M, int N, int G_, int c_) { nM = M / BM; nN = N / BM; nwg = nM * nN; G = G_; c = c_; }
    __device__ bool next(int i, Unit& u) const {
        const long L = (long)i * G + c; if (L >= nwg) return false;
        int wgid = (int)L; { const int q = nwg / NXCD, r = nwg % NXCD, xcd = wgid % NXCD, off = wgid / NXCD; wgid = (xcd < r ? xcd * (q + 1) : r * (q + 1) + (xcd - r) * q) + off; }
        const int nig = WGM * nN, gid = wgid / nig, fm = gid * WGM, gsz = (nM - fm) < WGM ? (nM - fm) : WGM;
        u.pm = fm + ((wgid % nig) % gsz); u.pn = (wgid % nig) / gsz; u.brow = u.pn * BM; return true;
    }
};
struct MoeOrder {
    const int* tiles; int G, c, rows_per_expert;
    __device__ bool next(int i, Unit& u) const {
        const int nt = tiles[0]; const int L = i * G + c; if (L >= nt * 4) return false;
        const int t = L >> 2; u.pm = t; u.pn = L & 3; u.brow = tiles[1 + t] * rows_per_expert + u.pn * BM; return true;
    }
};

struct EpiF32 {
    static constexpr bool PERM = false;
    float* C; int ldc;
    __device__ __forceinline__ void operator()(const f32x4 (&acc)[2][2][4][2], const Unit& u, int wr, int wc, int fr, int fq) const {
        const int row0 = u.pm * BM + wr * 64 + fr, col0 = u.pn * BM + wc * 32 + 4 * fq;
#pragma unroll
        for (int ai = 0; ai < 2; ++ai)
#pragma unroll
            for (int m = 0; m < 4; ++m) { float* rowp = C + (size_t)(row0 + ai * HALF + m * 16) * ldc + col0;
#pragma unroll
                for (int bj = 0; bj < 2; ++bj)
#pragma unroll
                    for (int n = 0; n < 2; ++n) *(f32x4*)(rowp + bj * HALF + n * 16) = acc[ai][bj][m][n]; }
    }
};
struct EpiBf16 {
    static constexpr bool PERM = true;
    bf16_t* O; int ldc; int split_cols; size_t split_stride;
    __device__ __forceinline__ void operator()(const f32x4 (&acc)[2][2][4][2], const Unit& u, int wr, int wc, int fr, int fq) const {
        const int row0 = u.pm * BM + wr * 64 + fr; int colt = u.pn * BM; bf16_t* base = O;
        if (split_cols) { const int t = colt / split_cols; base += (size_t)t * split_stride; colt -= t * split_cols; }
        const int col0 = colt + wc * 32 + 8 * fq;
#pragma unroll
        for (int ai = 0; ai < 2; ++ai)
#pragma unroll
            for (int m = 0; m < 4; ++m) { bf16_t* rowp = base + (size_t)(row0 + ai * HALF + m * 16) * ldc + col0;
#pragma unroll
                for (int bj = 0; bj < 2; ++bj) { const f32x4 v0 = acc[ai][bj][m][0], v1 = acc[ai][bj][m][1];
                    u32x4 w; w.x = cvtpk(v0[0], v0[1]); w.y = cvtpk(v0[2], v0[3]); w.z = cvtpk(v1[0], v1[1]); w.w = cvtpk(v1[2], v1[3]);
                    *(u32x4*)(rowp + bj * HALF) = w; } }
    }
};
struct EpiGU {
    static constexpr bool PERM = true;
    bf16_t* H; int ldh;
    __device__ __forceinline__ void operator()(const f32x4 (&acc)[2][2][4][2], const Unit& u, int wr, int wc, int fr, int fq) const {
        const int row0 = u.pm * BM + wr * 64 + fr, col0 = u.pn * HALF + wc * 32 + 8 * fq;
#pragma unroll
        for (int ai = 0; ai < 2; ++ai)
#pragma unroll
            for (int m = 0; m < 4; ++m) { bf16_t* rowp = H + (size_t)(row0 + ai * HALF + m * 16) * ldh + col0;
                float h[8];
#pragma unroll
                for (int n = 0; n < 2; ++n)
#pragma unroll
                    for (int j = 0; j < 4; ++j) h[n * 4 + j] = silu_f(acc[ai][0][m][n][j]) * acc[ai][1][m][n][j];
                u32x4 w; w.x = cvtpk(h[0], h[1]); w.y = cvtpk(h[2], h[3]); w.z = cvtpk(h[4], h[5]); w.w = cvtpk(h[6], h[7]);
                *(u32x4*)rowp = w; }
    }
};
struct EpiDown {
    static constexpr bool PERM = true; static constexpr bool ROWINFO_LDS = true;
    bf16_t* YS; const int2* rowinfo;
    __device__ __forceinline__ void operator()(const f32x4 (&acc)[2][2][4][2], const Unit& u, int wr, int wc, int fr, int fq, const LAS i32x2* ril) const {
        const int lrow0 = wr * 64 + fr, col0 = u.pn * BM + wc * 32 + 8 * fq;
#pragma unroll
        for (int ai = 0; ai < 2; ++ai)
#pragma unroll
            for (int m = 0; m < 4; ++m) { const i32x2 ri = ril[lrow0 + ai * HALF + m * 16];
                if (ri.x >= 0) { const float g = __int_as_float(ri.y); const int tok = ri.x >> 1, k = ri.x & 1;
                    bf16_t* rowp = YS + ((size_t)k * NTOK + tok) * DM + col0;
#pragma unroll
                    for (int bj = 0; bj < 2; ++bj) { const f32x4 v0 = acc[ai][bj][m][0] * g, v1 = acc[ai][bj][m][1] * g;
                        u32x4 w; w.x = cvtpk(v0[0], v0[1]); w.y = cvtpk(v0[2], v0[3]); w.z = cvtpk(v1[0], v1[1]); w.w = cvtpk(v1[2], v1[3]);
                        *(u32x4*)(rowp + bj * HALF) = w; } } }
    }
};

template <int NRMS, bool ROPE, bool KSKIP> struct EpiNormUp {
    static constexpr bool PERM = true;
    bf16_t* O; int ldc; int split_cols; size_t split_stride; const bf16_t* Zs; int ldz; const float* cosT; const float* sinT;
    __device__ __forceinline__ void operator()(const f32x4 (&acc)[2][2][4][2], const Unit& u, int wr, int wc, int fr_, int fq_) const {
        int fr = fr_, fq = fq_; asm volatile("" : "+v"(fr), "+v"(fq));
        const int row0 = u.pm * BM + wr * 64 + fr; int colt = u.pn * BM; bf16_t* base = O; bool kpart = false;
        if (split_cols) { const int t = colt / split_cols; base += (size_t)t * split_stride; colt -= t * split_cols; kpart = (t == 0); }
        if (KSKIP && kpart && wc >= 2) return;
        const int col0 = colt + wc * 32 + 8 * fq;
        constexpr int NL = NRMS > 0 ? NRMS / 32 : 1;
#pragma unroll
        for (int ai = 0; ai < 2; ++ai) {
            float rstd[4] = {1.f, 1.f, 1.f, 1.f};
            constexpr int RB = (NRMS > 128) ? 1 : 2;
            if constexpr (NRMS > 0) {
#pragma unroll
            for (int mp = 0; mp < 4; mp += RB) {
                u32x4 zw[RB][NL];
#pragma unroll
                for (int m2 = 0; m2 < RB; ++m2)
#pragma unroll
                    for (int q = 0; q < NL; ++q) zw[m2][q] = *(const u32x4*)(Zs + (size_t)(row0 + ai * HALF + (mp + m2) * 16) * ldz + fq * (NRMS / 4) + q * 8);
#pragma unroll
                for (int m2 = 0; m2 < RB; ++m2) { float ss = 0.f;
#pragma unroll
                    for (int q = 0; q < NL; ++q) { const u32x4 w = zw[m2][q]; const float a0 = bflo(w.x), a1 = bfhi(w.x), a2 = bflo(w.y), a3 = bfhi(w.y), a4 = bflo(w.z), a5 = bfhi(w.z), a6 = bflo(w.w), a7 = bfhi(w.w);
                        ss += (a0 * a0 + a1 * a1) + (a2 * a2 + a3 * a3) + (a4 * a4 + a5 * a5) + (a6 * a6 + a7 * a7); }
                    ss += __shfl_xor(ss, 16); ss += __shfl_xor(ss, 32);
                    rstd[mp + m2] = 1.f / sqrtf(ss * (1.f / (NRMS > 0 ? NRMS : 1)) + 1e-6f); }
                __builtin_amdgcn_sched_barrier(0);
            } }
#pragma unroll
            for (int m = 0; m < 4; ++m) { const int row = row0 + ai * HALF + m * 16; bf16_t* rowp = base + (size_t)row * ldc + col0;
                f32x4 cs = {1.f, 1.f, 1.f, 1.f}, sn = {0.f, 0.f, 0.f, 0.f};
                if (ROPE && wc == 2) { const int pos = row & (SEQ - 1); cs = *(const f32x4*)(cosT + (size_t)pos * 16 + 4 * fq); sn = *(const f32x4*)(sinT + (size_t)pos * 16 + 4 * fq); }
#pragma unroll
                for (int bj = 0; bj < 2; ++bj) { f32x4 v0 = acc[ai][bj][m][0] * rstd[m], v1 = acc[ai][bj][m][1] * rstd[m];
                    if (ROPE && wc == 2) {
                        const f32x4 a = v0, b = v1;
                        v0[0] = a[0] * cs[0] - a[1] * sn[0]; v0[1] = a[1] * cs[0] + a[0] * sn[0]; v0[2] = a[2] * cs[1] - a[3] * sn[1]; v0[3] = a[3] * cs[1] + a[2] * sn[1];
                        v1[0] = b[0] * cs[2] - b[1] * sn[2]; v1[1] = b[1] * cs[2] + b[0] * sn[2]; v1[2] = b[2] * cs[3] - b[3] * sn[3]; v1[3] = b[3] * cs[3] + b[2] * sn[3]; }
                    u32x4 w; w.x = cvtpk(v0[0], v0[1]); w.y = cvtpk(v0[2], v0[3]); w.z = cvtpk(v1[0], v1[1]); w.w = cvtpk(v1[2], v1[3]);
                    *(u32x4*)(rowp + bj * HALF) = w; } }
        }
    }
};

template <class T, class = void> struct epi_rowinfo_lds { static constexpr bool value = false; };
template <class T> struct epi_rowinfo_lds<T, decltype((void)T::ROWINFO_LDS)> { static constexpr bool value = T::ROWINFO_LDS; };
template <class Epi, class Sched, bool ALIGN_EPI, bool GATHER = false>
__device__ __forceinline__ void gemm_phase(LAS unsigned char* lds, const Gemm g, const Sched& S, const Epi& E, int WV_, const int2* rowinfo = nullptr) {
    const int tid = otid(), wid = __builtin_amdgcn_readfirstlane(tid >> 6), lane = tid & 63, wr = wid >> 2, wc = wid & 3, fr = lane & 15, fq = lane >> 4;
    const int K = g.K, nt = K / BK;
    unsigned voffA[2], voffB[2], voffA1[2] = {0u, 0u}, nvoffA[2] = {0u, 0u}, nvoffA1[2] = {0u, 0u};
    int stR[2], stC[2];
#pragma unroll
    for (int i = 0; i < 2; ++i) { int R, C; stage_rc(tid * 16 + i * 8192, R, C); const int Rb = Epi::PERM ? ((R & ~31) + perm32(R & 31)) : R; stR[i] = R; stC[i] = C;
        voffA[i] = (unsigned)(R * g.lda + C) * 2u; voffB[i] = (unsigned)(Rb * g.ldb + C) * 2u; }
#define PG8_GOFF(o0, o1, pm_) do { _Pragma("unroll") for (int _i = 0; _i < 2; ++_i) { const int r0_ = (pm_) * BM + stR[_i]; const int t0_ = rowinfo[r0_].x, t1_ = rowinfo[r0_ + HALF].x; \
        (o0)[_i] = (unsigned)(((t0_ < 0 ? 0 : t0_) >> 1) * g.lda + stC[_i]) * 2u; (o1)[_i] = (unsigned)(((t1_ < 0 ? 0 : t1_) >> 1) * g.lda + stC[_i]) * 2u; } } while (0)
#define PG8_STAGE_A(bufoff, a, h, o0, o1) do { if constexpr (GATHER) { if (h) PG8_STAGE(bufoff, a, o1); else PG8_STAGE(bufoff, a, o0); } else PG8_STAGE(bufoff, (a) + (h) * hstepA, voffA); } while (0)
    const size_t kstep = (size_t)(BK * 2);
    const size_t hstepA = (size_t)HALF * g.lda * 2, hstepB = (size_t)HALF * g.ldb * 2;
    const unsigned ldsw = (unsigned)wid * 1024u;
    const int aoff = lds_byte(wr * 64 + fr, fq * 8), boff = lds_byte(wc * 32 + fr, fq * 8);
#define PG8_SA(b, h) (((b) * 2 + (h)) * HTB)
#define PG8_SB(b, h) ((4 + (b) * 2 + (h)) * HTB)
#define PG8_STAGE(bufoff, gbase, voff) do { _Pragma("unroll") for (int _i = 0; _i < 2; ++_i) \
        __builtin_amdgcn_global_load_lds((const unsigned*)((const char*)(gbase) + (voff)[_i]), (LAS unsigned*)(lds + (bufoff) + ldsw + _i * 8192), 16, 0, 0); } while (0)
#define PG8_LDA(dst, b, h) do { _Pragma("unroll") for (int m = 0; m < 4; ++m) _Pragma("unroll") for (int k = 0; k < 2; ++k) dst[m][k] = *(const LAS bf16x8*)(lds + PG8_SA(b, h) + aoff + m * 2048 + k * 1024); } while (0)
#define PG8_LDB(dst, b, h) do { _Pragma("unroll") for (int n = 0; n < 2; ++n) _Pragma("unroll") for (int k = 0; k < 2; ++k) dst[n][k] = *(const LAS bf16x8*)(lds + PG8_SB(b, h) + boff + n * 2048 + k * 1024); } while (0)
#define PG8_MMA(ai, bj, At, Bt) do { __builtin_amdgcn_s_setprio(1); _Pragma("unroll") for (int m = 0; m < 4; ++m) _Pragma("unroll") for (int n = 0; n < 2; ++n) _Pragma("unroll") for (int k = 0; k < 2; ++k) \
        acc[ai][bj][m][n] = __builtin_amdgcn_mfma_f32_16x16x32_bf16(Bt[n][k], At[m][k], acc[ai][bj][m][n], 0, 0, 0); __builtin_amdgcn_s_setprio(0); } while (0)
#define PG8_WAIT_V(n) asm volatile("s_waitcnt vmcnt(" #n ")" ::: "memory")
#define PG8_WAIT_L(n) asm volatile("s_waitcnt lgkmcnt(" #n ")" ::: "memory")
#define PG8_BAR __builtin_amdgcn_s_barrier()
#define PG8_SCHED __builtin_amdgcn_sched_barrier(0)
    Unit cur, nxt; int ui = 0;
    if (!S.next(0, cur)) return;
    f32x4 acc[2][2][4][2];
#pragma unroll
    for (int a = 0; a < 2; ++a)
#pragma unroll
        for (int b = 0; b < 2; ++b)
#pragma unroll
            for (int m = 0; m < 4; ++m)
#pragma unroll
                for (int n = 0; n < 2; ++n) acc[a][b][m][n] = (f32x4){0.f, 0.f, 0.f, 0.f};
    bf16x8 At[4][2], B0[2][2], B1[2][2];
    const char* cA = (const char*)g.A + (GATHER ? (size_t)0 : (size_t)cur.pm * 2 * hstepA); const char* cB = (const char*)g.Bt + (size_t)cur.brow * g.ldb * 2;
    if constexpr (GATHER) { PG8_GOFF(voffA, voffA1, cur.pm); }
    PG8_STAGE(PG8_SB(0, 0), cB, voffB); PG8_STAGE(PG8_SB(0, 1), cB + hstepB, voffB); PG8_STAGE_A(PG8_SA(0, 0), cA, 0, voffA, voffA1); PG8_STAGE_A(PG8_SA(0, 1), cA, 1, voffA, voffA1);
    if (wr == 1) PG8_BAR;
    PG8_WAIT_V(2); PG8_BAR;
    PG8_STAGE(PG8_SB(1, 0), cB + kstep, voffB); PG8_STAGE_A(PG8_SA(1, 0), cA + kstep, 0, voffA, voffA1); PG8_STAGE(PG8_SB(1, 1), cB + hstepB + kstep, voffB);
    PG8_WAIT_V(6); PG8_BAR;
    for (;;) {
        if constexpr (epi_rowinfo_lds<Epi>::value) {
            if (tid < 256) { const int2 rv = E.rowinfo[cur.pm * BM + tid]; ((LAS i32x2*)(lds + 132096 + (ui & 1) * 2048))[tid] = (i32x2){rv.x, rv.y}; } }
        const bool has_next = S.next(ui + 1, nxt);
        const char* nA = has_next ? (const char*)g.A + (GATHER ? (size_t)0 : (size_t)nxt.pm * 2 * hstepA) : cA; const char* nB = has_next ? (const char*)g.Bt + (size_t)nxt.brow * g.ldb * 2 : cB;
        if constexpr (GATHER) {
            if (has_next) { PG8_GOFF(nvoffA, nvoffA1, nxt.pm); } else { nvoffA[0] = voffA[0]; nvoffA[1] = voffA[1]; nvoffA1[0] = voffA1[0]; nvoffA1[1] = voffA1[1]; }
            asm volatile("s_waitcnt vmcnt(0)" : "+v"(nvoffA[0]), "+v"(nvoffA[1]), "+v"(nvoffA1[0]), "+v"(nvoffA1[1]) :: "memory"); }
        for (int t = 0; t < nt; t += 2) {
            const bool last = (t == nt - 2);
            const char* a1 = cA + (size_t)(t + 1) * kstep;
            const char* a2 = last ? nA : cA + (size_t)(t + 2) * kstep; const char* b2 = last ? nB : cB + (size_t)(t + 2) * kstep;
            const char* a3 = a2 + kstep; const char* b3 = b2 + kstep;
            unsigned xo0[2], xo1[2];
#pragma unroll
            for (int _i = 0; _i < 2; ++_i) { xo0[_i] = last ? nvoffA[_i] : voffA[_i]; xo1[_i] = last ? nvoffA1[_i] : voffA1[_i]; }
            PG8_LDB(B0, 0, 0); PG8_LDB(B1, 0, 1); PG8_SCHED; PG8_LDA(At, 0, 0); PG8_STAGE_A(PG8_SA(1, 1), a1, 1, voffA, voffA1);
            PG8_WAIT_V(8); PG8_WAIT_L(0); PG8_BAR; PG8_MMA(0, 0, At, B0); PG8_MMA(0, 1, At, B1); PG8_BAR; PG8_SCHED;
            PG8_LDA(At, 0, 1); PG8_STAGE(PG8_SB(0, 0), b2, voffB); PG8_STAGE(PG8_SB(0, 1), b2 + hstepB, voffB); PG8_STAGE_A(PG8_SA(0, 0), a2, 0, xo0, xo1);
            PG8_WAIT_V(8); PG8_WAIT_L(0); PG8_BAR; PG8_MMA(1, 0, At, B0); PG8_MMA(1, 1, At, B1); PG8_BAR; PG8_SCHED;
            PG8_LDB(B0, 1, 0); PG8_LDB(B1, 1, 1); PG8_SCHED; PG8_LDA(At, 1, 0); PG8_STAGE_A(PG8_SA(0, 1), a2, 1, xo0, xo1);
            PG8_WAIT_V(8); PG8_WAIT_L(0); PG8_BAR; PG8_MMA(0, 0, At, B0); PG8_MMA(0, 1, At, B1); PG8_BAR; PG8_SCHED;
            PG8_LDA(At, 1, 1); PG8_STAGE(PG8_SB(1, 0), b3, voffB); PG8_STAGE(PG8_SB(1, 1), b3 + hstepB, voffB); PG8_STAGE_A(PG8_SA(1, 0), a3, 0, xo0, xo1);
            PG8_WAIT_V(8); PG8_WAIT_L(0); PG8_BAR; PG8_MMA(1, 0, At, B0); PG8_MMA(1, 1, At, B1); PG8_BAR; PG8_SCHED;
        }
        if constexpr (ALIGN_EPI) { if (wr == 0) PG8_BAR; }
        if constexpr (epi_rowinfo_lds<Epi>::value) E(acc, cur, wr, wc, fr, fq, (const LAS i32x2*)(lds + 132096 + (ui & 1) * 2048));
        else E(acc, cur, wr, wc, fr, fq);
        if (!has_next) break;
#pragma unroll
        for (int a = 0; a < 2; ++a)
#pragma unroll
            for (int b = 0; b < 2; ++b)
#pragma unroll
                for (int m = 0; m < 4; ++m)
#pragma unroll
                    for (int n = 0; n < 2; ++n) acc[a][b][m][n] = (f32x4){0.f, 0.f, 0.f, 0.f};
        cur = nxt; cA = nA; cB = nB; ++ui;
        if constexpr (GATHER) { voffA[0] = nvoffA[0]; voffA[1] = nvoffA[1]; voffA1[0] = nvoffA1[0]; voffA1[1] = nvoffA1[1]; }
        if constexpr (ALIGN_EPI) { if (wr == 1) PG8_BAR; }
    }
    PG8_WAIT_V(0);
    if constexpr (!ALIGN_EPI) { if (wr == 0) PG8_BAR; }
    PG8_BAR;
#undef PG8_SA
#undef PG8_SB
#undef PG8_STAGE
#undef PG8_STAGE_A
#undef PG8_GOFF
#undef PG8_LDA
#undef PG8_LDB
#undef PG8_MMA
#undef PG8_WAIT_V
#undef PG8_WAIT_L
#undef PG8_BAR
#undef PG8_SCHED
}
}

namespace att {
constexpr int NW = 8, QBLK = 32, KVBLK = 64;
constexpr float THR = 8.f;
constexpr size_t SHM_V = KVBLK * 128 * 2, SHM_K = KVBLK * 128 * 2, SHM_ATTN = 2 * SHM_V + 2 * SHM_K + NW * 64 * 4;
#define KSWZ(row, colB) ((row) * 256 + ((colB) ^ (((row) & 7) << 4)))
#define KSWZ64(row, colB) ((row) * 128 + ((colB) ^ (((row) & 7) << 4)))
#define SBAR() __builtin_amdgcn_sched_barrier(0)
__device__ __forceinline__ int crow(int r, int hi) { return (r & 3) + 8 * (r >> 2) + 4 * hi; }
__device__ __forceinline__ bf16x8 ld8(const bf16_t* p) { return *reinterpret_cast<const bf16x8*>(p); }

__device__ __forceinline__ void partialSM(f32x16& p0, f32x16& p1, float& m_reg, float& mn, float& alpha, float C, float thr_raw) {
  float pmax = p0[0];
#pragma unroll
  for (int r = 1; r < 16; ++r) pmax = fmaxf(pmax, p0[r]);
#pragma unroll
  for (int r = 0; r < 16; ++r) pmax = fmaxf(pmax, p1[r]);
  { auto rr = __builtin_amdgcn_permlane32_swap(__float_as_uint(pmax), __float_as_uint(pmax), false, false);
    pmax = fmaxf(__uint_as_float(rr[0]), __uint_as_float(rr[1])); }
  if (__builtin_expect(__all(pmax - m_reg <= thr_raw), 1)) { mn = m_reg; alpha = 1.f; }
  else { mn = fmaxf(m_reg, pmax); alpha = __builtin_amdgcn_exp2f((m_reg - mn) * C); m_reg = mn; }
  float mnC = -mn * C;
#pragma unroll
  for (int r = 0; r < 16; ++r) p0[r] = fmaf(p0[r], C, mnC);
#pragma unroll
  for (int r = 0; r < 16; ++r) p1[r] = fmaf(p1[r], C, mnC);
#pragma unroll
  for (int r = 0; r < 16; ++r) p0[r] = __builtin_amdgcn_exp2f(p0[r]);
}
#define PK4(P, BASE, OUT) do { u32x4 w = {cvtpk(P[BASE + 0], P[BASE + 1]), cvtpk(P[BASE + 2], P[BASE + 3]), cvtpk(P[BASE + 4], P[BASE + 5]), cvtpk(P[BASE + 6], P[BASE + 7])}; \
    OUT = *reinterpret_cast<bf16x8*>(&w); } while (0)
__device__ __forceinline__ void finishSM(f32x16& p0, f32x16& p1, bf16x8& pa0, bf16x8& pa1, bf16x8& pa2, bf16x8& pa3) {
#pragma unroll
  for (int r = 0; r < 16; ++r) p1[r] = __builtin_amdgcn_exp2f(p1[r]);
  PK4(p0, 0, pa0); PK4(p0, 8, pa1); PK4(p1, 0, pa2); PK4(p1, 8, pa3);
}
template <int D0_LO, int D0_HI>
__device__ __forceinline__ void qkt(f32x16& p0, f32x16& p1, const bf16_t* Ks, const bf16x8* qr, int r32, int hi) {
  p0 = f32x16{}; p1 = f32x16{};
#pragma unroll
  for (int d0 = D0_LO; d0 < D0_HI; ++d0) { int cb = (d0 * 16 + hi * 8) * 2;
    bf16x8 b0 = *reinterpret_cast<const bf16x8*>((const char*)Ks + KSWZ(r32, cb));
    bf16x8 b1 = *reinterpret_cast<const bf16x8*>((const char*)Ks + KSWZ(32 + r32, cb));
    p0 = __builtin_amdgcn_mfma_f32_32x32x16_bf16(b0, qr[d0], p0, 0, 0, 0);
    p1 = __builtin_amdgcn_mfma_f32_32x32x16_bf16(b1, qr[d0], p1, 0, 0, 0); }
}
__device__ __forceinline__ void qkt64(f32x16& p0, f32x16& p1, const bf16_t* Ks, const bf16x8* qr, int r32, int hi) {
  p0 = f32x16{}; p1 = f32x16{};
#pragma unroll
  for (int d0 = 0; d0 < 4; ++d0) { int cb = (d0 * 16 + hi * 8) * 2;
    bf16x8 b0 = *reinterpret_cast<const bf16x8*>((const char*)Ks + KSWZ64(r32, cb));
    bf16x8 b1 = *reinterpret_cast<const bf16x8*>((const char*)Ks + KSWZ64(32 + r32, cb));
    p0 = __builtin_amdgcn_mfma_f32_32x32x16_bf16(b0, qr[d0], p0, 0, 0, 0);
    p1 = __builtin_amdgcn_mfma_f32_32x32x16_bf16(b1, qr[d0], p1, 0, 0, 0); }
}
__device__ __forceinline__ int v_st(int k, int c) { const int kk = k; return ((kk >> 3) * 4 + (c >> 5)) * 512 + ((kk & 7) * 32 + (c & 31)) * 2; }
__device__ __forceinline__ int v_rd_base(int lane) { return ((lane & 3) << 3) | (((lane >> 2) & 3) << 6) | (((lane >> 4) & 1) << 5) | (((lane >> 5) & 1) << 8); }
__host__ __device__ constexpr int v_rd_off(int d0, int ks, int half) { return d0 * 512 + ks * 4096 + half * 2048; }
template <int OFF> __device__ __forceinline__ s16x4 tr_read(int vb) {
  s16x4 r; asm volatile("ds_read_b64_tr_b16 %0, %1 offset:%2" : "=&v"(r) : "v"(vb), "i"(OFF) : "memory"); return r;
}
template <int D0> __device__ __forceinline__ void pv_one(f32x16& od, int vb, bf16x8 pa0, bf16x8 pa1, bf16x8 pa2, bf16x8 pa3) {
  const s16x4 l0 = tr_read<v_rd_off(D0, 0, 0)>(vb), h0 = tr_read<v_rd_off(D0, 0, 1)>(vb), l1 = tr_read<v_rd_off(D0, 1, 0)>(vb), h1 = tr_read<v_rd_off(D0, 1, 1)>(vb);
  const s16x4 l2 = tr_read<v_rd_off(D0, 2, 0)>(vb), h2 = tr_read<v_rd_off(D0, 2, 1)>(vb), l3 = tr_read<v_rd_off(D0, 3, 0)>(vb), h3 = tr_read<v_rd_off(D0, 3, 1)>(vb);
  asm volatile("s_waitcnt lgkmcnt(0)" ::: "memory"); SBAR();
#define PKV(L, H) (bf16x8){L[0], L[1], L[2], L[3], H[0], H[1], H[2], H[3]}
  od = __builtin_amdgcn_mfma_f32_32x32x16_bf16(pa0, PKV(l0, h0), od, 0, 0, 0);
  od = __builtin_amdgcn_mfma_f32_32x32x16_bf16(pa1, PKV(l1, h1), od, 0, 0, 0);
  od = __builtin_amdgcn_mfma_f32_32x32x16_bf16(pa2, PKV(l2, h2), od, 0, 0, 0);
  od = __builtin_amdgcn_mfma_f32_32x32x16_bf16(pa3, PKV(l3, h3), od, 0, 0, 0);
}
__device__ __forceinline__ void pv_l(f32x16* o, f32x16& l, int vb, bf16x8 pa0, bf16x8 pa1, bf16x8 pa2, bf16x8 pa3) {
  const bf16x8 ones = {0x3F80, 0x3F80, 0x3F80, 0x3F80, 0x3F80, 0x3F80, 0x3F80, 0x3F80};
  pv_one<0>(o[0], vb, pa0, pa1, pa2, pa3); l = __builtin_amdgcn_mfma_f32_32x32x16_bf16(pa0, ones, l, 0, 0, 0);
  pv_one<1>(o[1], vb, pa0, pa1, pa2, pa3); l = __builtin_amdgcn_mfma_f32_32x32x16_bf16(pa1, ones, l, 0, 0, 0);
  pv_one<2>(o[2], vb, pa0, pa1, pa2, pa3); l = __builtin_amdgcn_mfma_f32_32x32x16_bf16(pa2, ones, l, 0, 0, 0);
  pv_one<3>(o[3], vb, pa0, pa1, pa2, pa3); l = __builtin_amdgcn_mfma_f32_32x32x16_bf16(pa3, ones, l, 0, 0, 0);
}
__device__ __forceinline__ void pv_d0(f32x16* o, int vb, bf16x8 pa0, bf16x8 pa1, bf16x8 pa2, bf16x8 pa3) {
  pv_one<0>(o[0], vb, pa0, pa1, pa2, pa3); pv_one<1>(o[1], vb, pa0, pa1, pa2, pa3); pv_one<2>(o[2], vb, pa0, pa1, pa2, pa3); pv_one<3>(o[3], vb, pa0, pa1, pa2, pa3);
}

template <int D0_LO, int D0_HI, typename TO, bool DIFF = false>
__device__ __forceinline__ void attn_dense_body(const bf16_t* __restrict__ Qb, int ldq, const bf16_t* __restrict__ Kh, int ldk, const bf16_t* __restrict__ Vh, int ldv,
                                                TO* __restrict__ Ob, int ldo, int seq, float scale, char* lds,
                                                int WV_, const float* OA = nullptr, int ldoa = 0, float lam = 0.f, const float* subln = nullptr, const bf16_t* QN = nullptr, int ldqn = 0) {
  const int tid = otid(), wid = tid >> 6, lane = tid & 63, r32 = lane & 31, hi = lane >> 5;
  float C = scale * 1.4426950408889634f, thr_raw = THR / scale;
  if (QN) {
    const bf16_t* qn = QN + (long)(wid * QBLK + r32) * ldqn + hi * 128; float ss = 0.f;
#pragma unroll
    for (int q = 0; q < 16; ++q) { const u32x4 w = *(const u32x4*)(qn + q * 8); const float a0 = bflo(w.x), a1 = bfhi(w.x), a2 = bflo(w.y), a3 = bfhi(w.y), a4 = bflo(w.z), a5 = bfhi(w.z), a6 = bflo(w.w), a7 = bfhi(w.w);
      ss += (a0 * a0 + a1 * a1) + (a2 * a2 + a3 * a3) + (a4 * a4 + a5 * a5) + (a6 * a6 + a7 * a7); }
    ss += __shfl_xor(ss, 32);
    const float rq = 1.f / sqrtf(ss * (1.f / 256.f) + 1e-6f); C *= rq; thr_raw /= rq; }
  bf16_t* V_lds = (bf16_t*)lds; bf16_t* K_lds = (bf16_t*)(lds + 2 * SHM_V);
  float* ws = (float*)(lds + 2 * SHM_V + 2 * SHM_K) + wid * 64; float* al_l = ws + 32;
  float m_reg = -1e30f; f32x16 o[4] = {}; f32x16 lacc = {}; bf16x8 qr[8];
  const bf16_t* Qw = Qb + (long)(wid * QBLK + r32) * ldq + hi * 8;
#pragma unroll
  for (int d0 = 0; d0 < 8; ++d0) qr[d0] = (d0 >= D0_LO && d0 < D0_HI) ? ld8(Qw + d0 * 16) : bf16x8{};
  const int sr = tid >> 4, sc = (tid & 15) * 8, vst0 = v_st(sr, sc), vst1 = v_st(32 + sr, sc);
  const int vb0 = (int)(uintptr_t)V_lds + v_rd_base(lane);
  struct { bf16x8 vs0, vs1, ks0, ks1; } sr_[2];
  const bool kuse = (sc >= 16 * D0_LO) && (sc < 16 * D0_HI);
#define SLOAD(i, k0) do { sr_[i].vs0 = ld8(&Vh[(long)((k0) + sr) * ldv + sc]); sr_[i].vs1 = ld8(&Vh[(long)((k0) + 32 + sr) * ldv + sc]); \
    if (kuse) { sr_[i].ks0 = ld8(&Kh[(long)((k0) + sr) * ldk + sc]); sr_[i].ks1 = ld8(&Kh[(long)((k0) + 32 + sr) * ldk + sc]); } } while (0)
#define SWRITE(b, i) do { *(bf16x8*)((char*)V_lds + (b) * SHM_V + vst0) = sr_[i].vs0;          \
    *(bf16x8*)((char*)V_lds + (b) * SHM_V + vst1) = sr_[i].vs1; int kc = sc * 2;               \
    if (kuse) { *(bf16x8*)((char*)K_lds + (b) * SHM_K + KSWZ(sr, kc)) = sr_[i].ks0;                       \
    *(bf16x8*)((char*)K_lds + (b) * SHM_K + KSWZ(32 + sr, kc)) = sr_[i].ks1; } } while (0)
#define SWAIT() asm volatile("s_waitcnt vmcnt(4)" ::: "memory")
#define RESC(a) do { if (__any((a) < 1.f)) { if (hi == 0) al_l[r32] = (a); asm volatile("s_waitcnt lgkmcnt(0)" ::: "memory"); \
    _Pragma("unroll") for (int r = 0; r < 16; ++r) { const float av = al_l[crow(r, hi)]; lacc[r] *= av; _Pragma("unroll") for (int d = 0; d < 4; ++d) o[d][r] *= av; } } } while (0)
  f32x16 pA0, pA1, pB0, pB1; float mnA, mnB, alA, alB; bf16x8 pa0, pa1, pa2, pa3; const int NT = seq / KVBLK;
  constexpr int SE = 0, SO = 1;
  SLOAD(SE, 0); asm volatile("s_waitcnt vmcnt(0)" ::: "memory"); SWRITE(0, SE); __syncthreads();
  qkt<D0_LO, D0_HI>(pA0, pA1, K_lds, qr, r32, hi); partialSM(pA0, pA1, m_reg, mnA, alA, C, thr_raw);
  SLOAD(SO, KVBLK); if (2 < NT) SLOAD(SE, 2 * KVBLK);
  SWAIT(); SWRITE(1, SO); __syncthreads();
  for (int j = 1; j + 1 < NT; j += 2) {
    SBAR(); qkt<D0_LO, D0_HI>(pB0, pB1, (bf16_t*)((char*)K_lds + SHM_K), qr, r32, hi);
    finishSM(pA0, pA1, pa0, pa1, pa2, pa3); SBAR();
    SLOAD(SO, (j + 2) * KVBLK); SBAR();
    pv_l(o, lacc, vb0, pa0, pa1, pa2, pa3); partialSM(pB0, pB1, m_reg, mnB, alB, C, thr_raw);
    __syncthreads(); SWAIT(); SWRITE(0, SE);
    RESC(alB); __syncthreads();
    SBAR(); qkt<D0_LO, D0_HI>(pA0, pA1, K_lds, qr, r32, hi);
    finishSM(pB0, pB1, pa0, pa1, pa2, pa3); SBAR();
    if (j + 3 < NT) SLOAD(SE, (j + 3) * KVBLK); SBAR();
    pv_l(o, lacc, vb0 + (int)SHM_V, pa0, pa1, pa2, pa3); partialSM(pA0, pA1, m_reg, mnA, alA, C, thr_raw);
    __syncthreads(); SWAIT(); SWRITE(1, SO);
    RESC(alA); __syncthreads();
  }
  SBAR(); qkt<D0_LO, D0_HI>(pB0, pB1, (bf16_t*)((char*)K_lds + SHM_K), qr, r32, hi);
  finishSM(pA0, pA1, pa0, pa1, pa2, pa3); SBAR();
  pv_l(o, lacc, vb0, pa0, pa1, pa2, pa3); partialSM(pB0, pB1, m_reg, mnB, alB, C, thr_raw);
  __syncthreads(); RESC(alB);
  finishSM(pB0, pB1, pa0, pa1, pa2, pa3); SBAR();
  pv_l(o, lacc, vb0 + (int)SHM_V, pa0, pa1, pa2, pa3);
  float rli[16];
#pragma unroll
  for (int r = 0; r < 16; ++r) rli[r] = __builtin_amdgcn_rcpf(lacc[r]);
  TO* Ow = Ob + (long)(wid * QBLK) * ldo;
  if constexpr (DIFF) {
    const float* OA2 = OA; asm volatile("" : "+s"(OA2));
    const float* OAw = OA2 + (long)(wid * QBLK) * ldoa;
    float sg[4];
#pragma unroll
    for (int d0 = 0; d0 < 4; ++d0) sg[d0] = subln[d0 * 32 + r32] * 0.8f;
#pragma unroll
    for (int r = 0; r < 16; ++r) { int orow = crow(r, hi); float ov[4]; float ss = 0.f;
#pragma unroll
      for (int d0 = 0; d0 < 4; ++d0) { const float va = OAw[(long)orow * ldoa + d0 * 32 + r32]; ov[d0] = va - lam * (o[d0][r] * rli[r]); ss += ov[d0] * ov[d0]; }
      ss = half_sum(ss); const float rs = 1.f / sqrtf(ss * (1.f / 128.f) + 1e-6f);
#pragma unroll
      for (int d0 = 0; d0 < 4; ++d0) Ow[(long)orow * ldo + d0 * 32 + r32] = (TO)f2bf(ov[d0] * rs * sg[d0]); }
  } else {
#pragma unroll
  for (int r = 0; r < 16; ++r) { int orow = crow(r, hi);
#pragma unroll
    for (int d0 = 0; d0 < 4; ++d0) { const float val = o[d0][r] * rli[r];
      if constexpr (sizeof(TO) == 4) Ow[(long)orow * ldo + d0 * 32 + r32] = val; else Ow[(long)orow * ldo + d0 * 32 + r32] = (TO)f2bf(val); } }
  }
  __syncthreads();
#undef SLOAD
#undef SWRITE
#undef SWAIT
#undef RESC
}
}

namespace chk {
using att::crow; using att::v_st; using att::v_rd_base; using att::v_rd_off;
struct Cfg {
    const bf16_t* Z; int ld;
    int qcol, kcol, vcol, gcol;
    const float* BF; const float* BB;
    const float* dec_f; const float* dec_b;
    float qscale;
    bf16_t* U;
    bf16_t* OUT; int ldo; int ocol;
    const float* gain;
};
__device__ __forceinline__ s16x4 vtr(const LAS char* p) { return __builtin_bit_cast(s16x4, __builtin_amdgcn_ds_read_tr16_b64_v4i16((LAS v4i16_t*)p)); }
__device__ __forceinline__ bf16x8 trfrag(const LAS char* base, int d0, int ks) {
    const s16x4 l = vtr(base + v_rd_off(d0, ks, 0)), h = vtr(base + v_rd_off(d0, ks, 1));
    return (bf16x8){l[0], l[1], l[2], l[3], h[0], h[1], h[2], h[3]};
}
__device__ __forceinline__ void unpack8w(const u32x4 w, float* f) { f[0] = bflo(w.x); f[1] = bfhi(w.x); f[2] = bflo(w.y); f[3] = bfhi(w.y); f[4] = bflo(w.z); f[5] = bfhi(w.z); f[6] = bflo(w.w); f[7] = bfhi(w.w); }
__device__ __forceinline__ u32x4 scale8(u32x4 w, const float* s) {
    u32x4 o; o.x = cvtpk(bflo(w.x) * s[0], bfhi(w.x) * s[1]); o.y = cvtpk(bflo(w.y) * s[2], bfhi(w.y) * s[3]);
    o.z = cvtpk(bflo(w.z) * s[4], bfhi(w.z) * s[5]); o.w = cvtpk(bflo(w.w) * s[6], bfhi(w.w) * s[7]); return o;
}
__device__ __forceinline__ u32x4 scale8s(u32x4 w, float s) {
    u32x4 o; o.x = cvtpk(bflo(w.x) * s, bfhi(w.x) * s); o.y = cvtpk(bflo(w.y) * s, bfhi(w.y) * s);
    o.z = cvtpk(bflo(w.z) * s, bfhi(w.z) * s); o.w = cvtpk(bflo(w.w) * s, bfhi(w.w) * s); return o;
}

template <int DK, bool RET>
__device__ __forceinline__ void chunk_states(const Cfg& cf, char* lds, int unit, int WV_) {
    const int tid = otid(), wid = tid >> 6, lane = tid & 63, r32 = lane & 31, hi = lane >> 5;
    const int b = unit >> 7, c = unit & 127; const long row_base = (long)b * SEQ + (long)c * 64;
    constexpr int KG = DK / 8;
    const LAS char* L = (const LAS char*)lds;
    for (int hp = 0; hp < 2; ++hp) {
#pragma unroll
        for (int i = 0; i < 4; ++i) { const int p = tid + 512 * i, hl = p >> 10, row = (p >> 4) & 63, cg = p & 15, h = hp * 2 + hl;
            const bf16x8 v = att::ld8(cf.Z + (row_base + row) * cf.ld + cf.vcol + h * 128 + cg * 8);
            *(bf16x8*)(lds + hl * 16384 + v_st(row, cg * 8)) = v; }
#pragma unroll
        for (int i = 0; i < (2 * 64 * KG) / 512; ++i) { const int p = tid + 512 * i, hl = p / (64 * KG), row = (p / KG) % 64, cg = p % KG, h = hp * 2 + hl;
            const u32x4 kw = *(const u32x4*)(cf.Z + (row_base + row) * cf.ld + cf.kcol + h * DK + cg * 8);
            u32x4 kf, kb;
            if constexpr (RET) { const float laf = -__expf(cf.dec_f[h]), lab = -__expf(cf.dec_b[h]);
                kf = scale8s(kw, __expf((float)(63 - row) * laf)); kb = scale8s(kw, __expf((float)row * lab)); }
            else { const int col = h * 64 + cg * 8; float wf[8], wb[8];
                const f32x4 fl0 = *(const f32x4*)(cf.BF + (row_base + 63) * 256 + col), fl1 = *(const f32x4*)(cf.BF + (row_base + 63) * 256 + col + 4);
                const f32x4 fs0 = *(const f32x4*)(cf.BF + (row_base + row) * 256 + col), fs1 = *(const f32x4*)(cf.BF + (row_base + row) * 256 + col + 4);
                const f32x4 bl0 = *(const f32x4*)(cf.BB + row_base * 256 + col), bl1 = *(const f32x4*)(cf.BB + row_base * 256 + col + 4);
                const f32x4 bs0 = *(const f32x4*)(cf.BB + (row_base + row) * 256 + col), bs1 = *(const f32x4*)(cf.BB + (row_base + row) * 256 + col + 4);
#pragma unroll
                for (int j = 0; j < 4; ++j) { wf[j] = __expf(fl0[j] - fs0[j]); wf[4 + j] = __expf(fl1[j] - fs1[j]); wb[j] = __expf(bl0[j] - bs0[j]); wb[4 + j] = __expf(bl1[j] - bs1[j]); }
                kf = scale8(kw, wf); kb = scale8(kw, wb); }
            *(u32x4*)(lds + 32768 + hl * 16384 + v_st(row, cg * 8)) = kf;
            *(u32x4*)(lds + 65536 + hl * 16384 + v_st(row, cg * 8)) = kb; }
        __syncthreads();
        {
            const int hl = wid >> 2, dir = (wid >> 1) & 1, vh = wid & 1, h = hp * 2 + hl;
            const LAS char* vbV = L + hl * 16384 + v_rd_base(lane);
            const LAS char* vbK = L + 32768 + dir * 32768 + hl * 16384 + v_rd_base(lane);
            bf16_t* Ub = cf.U + ((((size_t)(b * 128 + c) * 4 + h) * 2 + dir) * 128) * DK;
#pragma unroll
            for (int ii = 0; ii < 2; ++ii) {
                f32x16 acc[DK / 32];
#pragma unroll
                for (int j = 0; j < DK / 32; ++j) acc[j] = f32x16{};
#pragma unroll
                for (int ks = 0; ks < 4; ++ks) {
                    const bf16x8 af = trfrag(vbV, vh * 2 + ii, ks);
#pragma unroll
                    for (int j = 0; j < DK / 32; ++j) { const bf16x8 bfr = trfrag(vbK, j, ks); acc[j] = __builtin_amdgcn_mfma_f32_32x32x16_bf16(af, bfr, acc[j], 0, 0, 0); }
                }
#pragma unroll
                for (int j = 0; j < DK / 32; ++j)
#pragma unroll
                    for (int r = 0; r < 16; ++r) Ub[(size_t)(32 * (vh * 2 + ii) + crow(r, hi)) * DK + 32 * j + r32] = f2bf(acc[j][r]);
                SBAR();
            }
        }
        __syncthreads();
    }
}

template <int DK, bool RET>
__device__ __forceinline__ void chunk_scan(const Cfg& cf, int chain) {
    constexpr int KH = DK / 2, NCH = 2 * 4 * 2 * 128 * KH;
    if (chain >= NCH) return;
    const int k2 = chain % KH, v = (chain / KH) % 128, dir = (chain / (KH * 128)) % 2, h = (chain / (KH * 256)) % 4, b = chain / (KH * 1024);
    const size_t cstride = (size_t)4 * 2 * 128 * DK;
    bf16_t* base = cf.U + ((((size_t)(b * 128) * 4 + h) * 2 + dir) * 128 + v) * DK + k2 * 2;
    float s0 = 0.f, s1 = 0.f, dsc = 0.f;
    if constexpr (RET) dsc = __expf(-64.f * __expf(dir ? cf.dec_b[h] : cf.dec_f[h]));
    constexpr int PF = 32;
    for (int c0 = 0; c0 < 128; c0 += PF) {
        unsigned u[PF]; f32x2 d[PF];
#pragma unroll
        for (int i = 0; i < PF; ++i) { const int c = dir ? (127 - c0 - i) : (c0 + i);
            u[i] = *(const unsigned*)(base + (size_t)c * cstride);
            if constexpr (!RET) d[i] = *(const f32x2*)((dir ? cf.BB + ((long)b * SEQ + c * 64) * 256 : cf.BF + ((long)b * SEQ + c * 64 + 63) * 256) + h * 64 + k2 * 2); }
#pragma unroll
        for (int i = 0; i < PF; ++i) { const int c = dir ? (127 - c0 - i) : (c0 + i);
            *(unsigned*)(base + (size_t)c * cstride) = cvtpk(s0, s1);
            float dd0 = dsc, dd1 = dsc;
            if constexpr (!RET) { dd0 = __expf(d[i][0]); dd1 = __expf(d[i][1]); }
            s0 = fmaf(dd0, s0, bflo(u[i])); s1 = fmaf(dd1, s1, bfhi(u[i])); }
    }
}

template <int DK, bool RET>
__device__ __forceinline__ void chunk_out(const Cfg& cf, char* lds, int unit, int WV_) {
    const int tid = otid(), wid = tid >> 6, lane = tid & 63, r32 = lane & 31, hi = lane >> 5;
    const int b = unit >> 7, c = unit & 127; const long row_base = (long)b * SEQ + (long)c * 64;
    constexpr int KG = DK / 8, ND0 = DK / 16, NKP = (4 * 64 * KG) / 512;
    {
        bf16x8 vv[8];
#pragma unroll
        for (int i = 0; i < 8; ++i) { const int p = tid + 512 * i, h = p >> 10, row = (p >> 4) & 63, cg = p & 15; vv[i] = att::ld8(cf.Z + (row_base + row) * cf.ld + cf.vcol + h * 128 + cg * 8); }
#pragma unroll
        for (int i = 0; i < 8; ++i) { const int p = tid + 512 * i, h = p >> 10, row = (p >> 4) & 63, cg = p & 15; *(bf16x8*)(lds + h * 16384 + v_st(row, cg * 8)) = vv[i]; }
    }
    {
        u32x4 kw[NKP];
#pragma unroll
        for (int i = 0; i < NKP; ++i) { const int p = tid + 512 * i, h = p / (64 * KG), row = (p / KG) % 64, cg = p % KG; kw[i] = *(const u32x4*)(cf.Z + (row_base + row) * cf.ld + cf.kcol + h * DK + cg * 8); }
        if constexpr (RET) {
#pragma unroll
            for (int i = 0; i < NKP; ++i) { const int p = tid + 512 * i, h = p / (64 * KG), row = (p / KG) % 64, cg = p % KG; *(u32x4*)(lds + 65536 + h * 16384 + KSWZ(row, cg * 16)) = kw[i]; }
        } else {
            f32x4 fs[NKP][2], bs[NKP][2];
#pragma unroll
            for (int i = 0; i < NKP; ++i) { const int p = tid + 512 * i, h = p / (64 * KG), row = (p / KG) % 64, cg = p % KG, col = h * 64 + cg * 8;
                fs[i][0] = *(const f32x4*)(cf.BF + (row_base + row) * 256 + col); fs[i][1] = *(const f32x4*)(cf.BF + (row_base + row) * 256 + col + 4);
                bs[i][0] = *(const f32x4*)(cf.BB + (row_base + row) * 256 + col); bs[i][1] = *(const f32x4*)(cf.BB + (row_base + row) * 256 + col + 4); }
#pragma unroll
            for (int i = 0; i < NKP; ++i) { const int p = tid + 512 * i, h = p / (64 * KG), row = (p / KG) % 64, cg = p % KG; float wf[8], wb[8];
#pragma unroll
                for (int jj = 0; jj < 4; ++jj) { wf[jj] = __expf(-fs[i][0][jj]); wf[4 + jj] = __expf(-fs[i][1][jj]); wb[jj] = __expf(-bs[i][0][jj]); wb[4 + jj] = __expf(-bs[i][1][jj]); }
                *(u32x4*)(lds + 65536 + h * 8192 + KSWZ64(row, cg * 16)) = scale8(kw[i], wf);
                *(u32x4*)(lds + 98304 + h * 8192 + KSWZ64(row, cg * 16)) = scale8(kw[i], wb); }
        }
    }
    __syncthreads();
    const int h = wid >> 1, rh = wid & 1, t = rh * 32 + r32;
    const long grow = row_base + t;
    bf16x8 qr[ND0];
#pragma unroll
    for (int d0 = 0; d0 < ND0; ++d0) qr[d0] = att::ld8(cf.Z + grow * cf.ld + cf.qcol + h * DK + d0 * 16 + hi * 8);
    f32x16 o[4] = {};
    float laf = 0.f, lab = 0.f;
    if constexpr (RET) { laf = -__expf(cf.dec_f[h]); lab = -__expf(cf.dec_b[h]); }
    bf16x8 qf[RET ? 1 : ND0], qb[RET ? 1 : ND0];
    if constexpr (!RET) {
#pragma unroll
        for (int d0 = 0; d0 < ND0; ++d0) { const int col = h * 64 + d0 * 16 + hi * 8; float ef[8], eb[8];
            const f32x4 f0 = *(const f32x4*)(cf.BF + grow * 256 + col), f1 = *(const f32x4*)(cf.BF + grow * 256 + col + 4);
            const f32x4 b0 = *(const f32x4*)(cf.BB + grow * 256 + col), b1 = *(const f32x4*)(cf.BB + grow * 256 + col + 4);
#pragma unroll
            for (int jj = 0; jj < 4; ++jj) { ef[jj] = __expf(f0[jj]) * cf.qscale; ef[4 + jj] = __expf(f1[jj]) * cf.qscale; eb[jj] = __expf(b0[jj]) * cf.qscale; eb[4 + jj] = __expf(b1[jj]) * cf.qscale; }
            const u32x4 qw = __builtin_bit_cast(u32x4, qr[d0]);
            qf[d0] = __builtin_bit_cast(bf16x8, scale8(qw, ef)); qb[d0] = __builtin_bit_cast(bf16x8, scale8(qw, eb)); }
    }
#pragma unroll
    for (int dir = 0; dir < 2; ++dir) {
        const bf16_t* Sb = cf.U + ((((size_t)(b * 128 + c) * 4 + h) * 2 + dir) * 128) * DK;
        float rs = 1.f;
        if constexpr (RET) rs = dir ? __expf((float)(64 - t) * lab) : __expf((float)(t + 1) * laf);
#pragma unroll
        for (int d2 = 0; d2 < ND0; d2 += 2) {
            bf16x8 bfr[2][4];
#pragma unroll
            for (int dd = 0; dd < 2; ++dd)
#pragma unroll
                for (int jv = 0; jv < 4; ++jv) bfr[dd][jv] = att::ld8(Sb + (size_t)(32 * jv + r32) * DK + (d2 + dd) * 16 + hi * 8);
#pragma unroll
            for (int dd = 0; dd < 2; ++dd) { const int d0 = d2 + dd; bf16x8 a;
                if constexpr (RET) a = __builtin_bit_cast(bf16x8, scale8s(__builtin_bit_cast(u32x4, qr[d0]), rs));
                else a = dir ? qb[d0] : qf[d0];
#pragma unroll
                for (int jv = 0; jv < 4; ++jv) o[jv] = __builtin_amdgcn_mfma_f32_32x32x16_bf16(a, bfr[dd][jv], o[jv], 0, 0, 0); }
            SBAR();
        }
    }
    f32x16 p0, p1;
    if constexpr (RET) {
        att::qkt<0, 8>(p0, p1, (const bf16_t*)(lds + 65536 + h * 16384), qr, r32, hi);
#pragma unroll
        for (int r = 0; r < 16; ++r) { const int s0 = crow(r, hi), s1 = 32 + s0;
            p0[r] *= (s0 <= t) ? __expf((float)(t - s0) * laf) : __expf((float)(s0 - t) * lab);
            p1[r] *= (s1 <= t) ? __expf((float)(t - s1) * laf) : __expf((float)(s1 - t) * lab); }
    } else {
        f32x16 q0, q1;
        att::qkt64(p0, p1, (const bf16_t*)(lds + 65536 + h * 8192), qf, r32, hi);
        att::qkt64(q0, q1, (const bf16_t*)(lds + 98304 + h * 8192), qb, r32, hi);
#pragma unroll
        for (int r = 0; r < 16; ++r) { const int s0 = crow(r, hi), s1 = 32 + s0;
            p0[r] = (s0 <= t) ? p0[r] : q0[r]; p1[r] = (s1 <= t) ? p1[r] : q1[r]; }
    }
    bf16x8 pa0, pa1, pa2, pa3;
    PK4(p0, 0, pa0); PK4(p0, 8, pa1); PK4(p1, 0, pa2); PK4(p1, 8, pa3);
    att::pv_d0(o, (int)(uintptr_t)lds + h * 16384 + v_rd_base(lane), pa0, pa1, pa2, pa3);
    float gn[4] = {1.f, 1.f, 1.f, 1.f};
    if constexpr (!RET) {
#pragma unroll
        for (int jv = 0; jv < 4; ++jv) gn[jv] = cf.gain[32 * jv + r32];
    }
    __syncthreads();
    bf16_t* Yt = (bf16_t*)(lds + 65536 + h * 16384);
#pragma unroll
    for (int r = 0; r < 16; ++r) { const int orow = rh * 32 + crow(r, hi);
        float y[4];
        if constexpr (RET) {
            const float mu = half_sum((o[0][r] + o[1][r]) + (o[2][r] + o[3][r])) * (1.f / 128.f);
            float q = 0.f;
#pragma unroll
            for (int jv = 0; jv < 4; ++jv) { y[jv] = o[jv][r] - mu; q += y[jv] * y[jv]; }
            const float rstd = 1.f / sqrtf(half_sum(q) * (1.f / 128.f) + 1e-5f);
#pragma unroll
            for (int jv = 0; jv < 4; ++jv) y[jv] *= rstd;
        } else {
            float q = 0.f;
#pragma unroll
            for (int jv = 0; jv < 4; ++jv) q += o[jv][r] * o[jv][r];
            const float rstd = 1.f / sqrtf(half_sum(q) * (1.f / 128.f) + 1e-6f);
#pragma unroll
            for (int jv = 0; jv < 4; ++jv) y[jv] = o[jv][r] * rstd * gn[jv];
        }
#pragma unroll
        for (int jv = 0; jv < 4; ++jv) Yt[orow * 128 + 32 * jv + r32] = f2bf(y[jv]);
    }
    __syncthreads();
    {
        const int tid2 = otid();
        u32x4 gw8[8];
#pragma unroll
        for (int i = 0; i < 8; ++i) { const int p = tid2 + 512 * i, hh = p >> 10, row = (p >> 4) & 63, cg = p & 15; gw8[i] = *(const u32x4*)(cf.Z + (row_base + row) * cf.ld + cf.gcol + hh * 128 + cg * 8); }
#pragma unroll
        for (int i = 0; i < 8; ++i) { const int p = tid2 + 512 * i, hh = p >> 10, row = (p >> 4) & 63, cg = p & 15;
            const u32x4 yw = *(const u32x4*)(lds + 65536 + hh * 16384 + row * 256 + cg * 16);
            float yf[8], gf[8]; unpack8w(yw, yf); unpack8w(gw8[i], gf);
#pragma unroll
            for (int e = 0; e < 8; ++e) yf[e] *= silu_f(gf[e]);
            u32x4 ow; ow.x = cvtpk(yf[0], yf[1]); ow.y = cvtpk(yf[2], yf[3]); ow.z = cvtpk(yf[4], yf[5]); ow.w = cvtpk(yf[6], yf[7]);
            *(u32x4*)(cf.OUT + (row_base + row) * cf.ldo + cf.ocol + hh * 128 + cg * 8) = ow; }
    }
    __syncthreads();
}
}

#define XB_TMO      128
#define XB_XCNT(j)  (256  + 64 * (j))
#define XB_XSUB(j)  (1280 + 64 * (j))
#define XB_XGEN(j)  (2304 + 64 * (j))
#define XB_TOP      3328
#define XB_TOPGEN   3392
#define XCD_BAR_WORDS 3456
#define XB_SPIN_CAP (1u << 18)
__device__ __forceinline__ unsigned xb_ld(unsigned* p)              { return __hip_atomic_load(p, __ATOMIC_RELAXED, __HIP_MEMORY_SCOPE_AGENT); }
__device__ __forceinline__ unsigned xb_add(unsigned* p, unsigned v) { return __hip_atomic_fetch_add(p, v, __ATOMIC_RELAXED, __HIP_MEMORY_SCOPE_AGENT); }
__device__ __forceinline__ unsigned xb_xcc_id() { return (unsigned)__builtin_amdgcn_s_getreg((3 << 11) | 20) & 0xFu; }
#define XB_SPIN(cond, bar) do { unsigned _sp = 0; while (cond) { __builtin_amdgcn_s_sleep(1); \
    if ((++_sp & 255u) == 0u) { if (xb_ld(&(bar)[XB_TMO])) break; if (_sp > XB_SPIN_CAP) { atomicAdd(&(bar)[XB_TMO], 1u); break; } } } } while (0)
struct XcdBarrier { unsigned* bar; unsigned x; volatile LAS unsigned* st; };
__device__ __forceinline__ XcdBarrier xcd_barrier_post(unsigned* bar, volatile LAS unsigned* st, int WV_) {
    XcdBarrier b; b.bar = bar; b.x = xb_xcc_id(); b.st = st;
    if (otid() == 0) (void)xb_add(&bar[XB_XCNT(b.x)], 1u);
    return b;
}
__device__ __forceinline__ void xcd_barrier_complete(unsigned* bar, unsigned x, unsigned& nloc, unsigned& nx) {
    const unsigned G = gridDim.x * gridDim.y * gridDim.z;
    unsigned sum, cnt, mine, sp = 0u;
    for (;;) {
        sum = 0u; cnt = 0u; mine = 0u;
#pragma unroll
        for (unsigned j = 0; j < 16; ++j) { const unsigned c = xb_ld(&bar[XB_XCNT(j)]); sum += c; cnt += (c > 0u) ? 1u : 0u; mine = (j == x) ? c : mine; }
        if (sum == G) break;
        __builtin_amdgcn_s_sleep(1);
        if ((++sp & 255u) == 0u) { if (xb_ld(&bar[XB_TMO])) break; if (sp > XB_SPIN_CAP) { atomicAdd(&bar[XB_TMO], 1u); break; } }
    }
    nloc = mine > 0u ? mine : 1u; nx = cnt > 0u ? cnt : 1u;
}
__device__ __forceinline__ void xcd_barrier(const XcdBarrier& b, int WV_) {
    asm volatile("s_waitcnt vmcnt(0)" ::: "memory");
    __syncthreads();
    if (otid() == 0) {
        unsigned* bar = b.bar;
        __builtin_amdgcn_s_waitcnt(0);
        unsigned nloc = b.st[0], nx = b.st[1];
        if (nloc == 0u) { xcd_barrier_complete(bar, b.x, nloc, nx); b.st[0] = nloc; b.st[1] = nx; }
        const unsigned old = xb_add(&bar[XB_XSUB(b.x)], 1u);
        const unsigned gen = old / nloc;
        if (old + 1u == (gen + 1u) * nloc) {
            __builtin_amdgcn_fence(__ATOMIC_RELEASE, "agent");
            asm volatile("s_waitcnt vmcnt(0)" ::: "memory");
            const unsigned og = xb_add(&bar[XB_TOP], 1u);
            const unsigned tg = og / nx;
            if (og + 1u == (tg + 1u) * nx) xb_add(&bar[XB_TOPGEN], 1u);
            else XB_SPIN(xb_ld(&bar[XB_TOPGEN]) == tg, bar);
            __builtin_amdgcn_fence(__ATOMIC_ACQUIRE, "agent");
            xb_add(&bar[XB_XGEN(b.x)], 1u);
            asm volatile("s_waitcnt vmcnt(0)" ::: "memory");
        } else {
            XB_SPIN(xb_ld(&bar[XB_XGEN(b.x)]) == gen, bar);
            __builtin_amdgcn_fence(__ATOMIC_ACQUIRE, "agent");
            asm volatile("s_waitcnt vmcnt(0)" ::: "memory");
        }
    }
    __syncthreads();
}

constexpr int NWAVES = 8;
constexpr int RING_BYTES = 131072, MISC_OFF = RING_BYTES + 320, LDS_BYTES = 147456;

struct Args { const float* in[32]; float* out; unsigned char* ws; int ph_lo, ph_hi; };
#define CAS __attribute__((address_space(4)))
#define KWS(A) ((unsigned char*)(((void* const volatile CAS*)__builtin_amdgcn_kernarg_segment_ptr())[33]))
#define KOUT(A) ((float*)(((void* const volatile CAS*)__builtin_amdgcn_kernarg_segment_ptr())[32]))
#define KARG(A, i) (((const float* const volatile CAS*)__builtin_amdgcn_kernarg_segment_ptr())[i])

template <class RowMap>
__device__ __forceinline__ void tr_item(const float* W, int ldw, int k0, int n0, bf16_t* WT, int ldk, const RowMap& rm, LAS float* scr, int lane, const float* gain = nullptr) {
    float tv[32];
#pragma unroll
    for (int i = 0; i < 32; ++i) { const int kk = 2 * i + (lane >> 5); tv[i] = W[(size_t)(k0 + kk) * ldw + n0 + (lane & 31)]; }
#pragma unroll
    for (int i = 0; i < 32; ++i) { const int kk = 2 * i + (lane >> 5); scr[kk * 33 + (lane & 31)] = tv[i]; }
    LDS_WAIT(); asm volatile("" ::: "memory");
    const int c = lane & 7;
    float gk[8];
#pragma unroll
    for (int e = 0; e < 8; ++e) gk[e] = gain ? gain[k0 + 8 * c + e] : 1.f;
#pragma unroll
    for (int j = 0; j < 4; ++j) { const int n = (lane >> 3) + 8 * j; const LAS float* s = scr + (8 * c) * 33 + n;
        u32x4 o; o.x = cvtpk(s[0 * 33] * gk[0], s[1 * 33] * gk[1]); o.y = cvtpk(s[2 * 33] * gk[2], s[3 * 33] * gk[3]); o.z = cvtpk(s[4 * 33] * gk[4], s[5 * 33] * gk[5]); o.w = cvtpk(s[6 * 33] * gk[6], s[7 * 33] * gk[7]);
        *(u32x4*)(WT + (size_t)rm(n0 + n) * ldk + k0 + 8 * c) = o; }
    LDS_WAIT(); asm volatile("" ::: "memory");
}
struct RmId { __device__ int operator()(int n) const { return n; } };
struct RmUq { __device__ int operator()(int n) const { const int h = n / 96, j = n % 96; if (j < 64) return h * 128 + j; const int i = j - 64; return h * 128 + 64 + ((i < 16) ? 2 * i : 2 * (i - 16) + 1); } };
struct RmUkv { __device__ int operator()(int n) const { const int h = n / 192, j = n % 192; return j < 64 ? h * 128 + j : 512 + h * 128 + (j - 64); } };
struct RmGU { int up; __device__ int operator()(int n) const { return (n >> 7) * 256 + up * 128 + (n & 127); } };

__device__ __forceinline__ void moe_weight_item(const Args& a, int layer, int r, LAS float* scr, int lane) {
    const int e = r / 768, q = r % 768;
    bf16_t* WGU = (bf16_t*)(KWS(a) + WS_WGU) + (size_t)e * 1024 * 1024; bf16_t* WDN = (bf16_t*)(KWS(a) + WS_WDN) + (size_t)e * 1024 * 512;
    const size_t eo = ((size_t)layer * 32 + e) * (size_t)(1024 * 512);
    if (q < 256) { tr_item(KARG(a, 29) + eo, 512, 64 * (q / 16), 32 * (q % 16), WGU, 1024, RmGU{0}, scr, lane); }
    else if (q < 512) { const int qq = q - 256; tr_item(KARG(a, 30) + eo, 512, 64 * (qq / 16), 32 * (qq % 16), WGU, 1024, RmGU{1}, scr, lane); }
    else { const int qq = q - 512; tr_item(KARG(a, 31) + eo, 1024, 64 * (qq / 32), 32 * (qq % 32), WDN, 512, RmId{}, scr, lane); }
}

__device__ __forceinline__ void p_prologue(const Args& a, char* lds, int vcu, int G, int WV_) {
    const int tid = otid(), lane = tid & 63, wave = tid >> 6;
    LAS float* scr = (LAS float*)((LAS char*)lds + wave * 16384);
    const int gw = vcu * NWAVES + wave, NGW = G * NWAVES;
    bf16_t* WIN0 = (bf16_t*)(KWS(a) + WS_WIN0); bf16_t* WOUT0 = (bf16_t*)(KWS(a) + WS_WOUT0); bf16_t* WIN1 = (bf16_t*)(KWS(a) + WS_WIN1); bf16_t* WOUT1 = (bf16_t*)(KWS(a) + WS_WOUT1);
    bf16_t* WUQ = (bf16_t*)(KWS(a) + WS_WUQ); bf16_t* WUKV = (bf16_t*)(KWS(a) + WS_WUKV);
    constexpr int I_IN0 = 16 * 112, I_OUT = 16 * 32, I_IN1 = 16 * 62, I_UQ = 4 * 12, I_UKV = 2 * 24, I_MOE = 32 * 768;
    constexpr int NITEMS = I_IN0 + 2 * I_OUT + I_IN1 + I_UQ + I_UKV + I_MOE;
    for (int it = gw; it < NITEMS; it += NGW) {
        int r = it;
        if (r < I_MOE) { moe_weight_item(a, 0, r, scr, lane); continue; } r -= I_MOE;
        if (r < I_IN0) { tr_item(KARG(a, 1), 3584, 64 * (r / 112), 32 * (r % 112), WIN0, 1024, RmId{}, scr, lane); continue; } r -= I_IN0;
        if (r < I_OUT) { tr_item(KARG(a, 9), 1024, 64 * (r / 32), 32 * (r % 32), WOUT0, 1024, RmId{}, scr, lane); continue; } r -= I_OUT;
        if (r < I_IN1) { tr_item(KARG(a, 10), 1984, 64 * (r / 62), 32 * (r % 62), WIN1, 1024, RmId{}, scr, lane); continue; } r -= I_IN1;
        if (r < I_OUT) { tr_item(KARG(a, 20), 1024, 64 * (r / 32), 32 * (r % 32), WOUT1, 1024, RmId{}, scr, lane); continue; } r -= I_OUT;
        if (r < I_UQ) { tr_item(KARG(a, 12), 384, 64 * (r / 12), 32 * (r % 12), WUQ, 256, RmUq{}, scr, lane, KARG(a, 11)); continue; } r -= I_UQ;
        tr_item(KARG(a, 14), 768, 64 * (r / 24), 32 * (r % 24), WUKV, 256, RmUkv{}, scr, lane, KARG(a, 13));
    }
    const int gt = vcu * 512 + tid, NT = G * 512;
    const u32x4 z4 = {0u, 0u, 0u, 0u};
    for (int i = gt; i < 64 * 128; i += NT) *(u32x4*)(WIN1 + (size_t)1984 * 1024 + (size_t)i * 8) = z4;
    for (int i = gt; i < 128 * 32; i += NT) { const int rr = i / 32, c8 = i % 32; *(u32x4*)(WUQ + (size_t)((rr / 32) * 128 + 96 + (rr % 32)) * 256 + c8 * 8) = z4; }
    for (int i = gt; i < 256 * 16; i += NT) { const int rr = i / 16, c8 = i % 16; *(u32x4*)(WUKV + (size_t)((rr / 64) * 128 + 64 + (rr % 64)) * 256 + c8 * 8) = z4; }
    for (int i = gt; i < 1024 * 16; i += NT) { const int rr = i / 16, c8 = i % 16; *(u32x4*)(WUKV + (size_t)rr * 256 + 128 + c8 * 8) = z4; }
    float* WR = (float*)(KWS(a) + WS_WR);
    for (int i = gt; i < 2 * 36 * 1024; i += NT) { const int l = i / (36 * 1024), j = (i / 1024) % 36, k = i % 1024;
        WR[i] = j < 4 ? KARG(a, 25)[((size_t)l * 1024 + k) * 4 + j] : KARG(a, 27)[((size_t)l * 1024 + k) * 32 + (j - 4)]; }
    float* TAB = (float*)(KWS(a) + WS_TAB);
    { const int P = NT / 88;
      if (gt < 88 * P) { const int q = gt % 88, p0 = gt / 88;
        double inv; float* tc; float* tsn; int stride, f;
        if (q < 64) { f = q; inv = pow(10000.0, -(double)q / 64.0); tc = TAB + TAB_COSR; tsn = TAB + TAB_SINR; stride = 64; }
        else if (q < 72) { f = q - 64; inv = pow(500000.0, -(double)f / 8.0); tc = TAB + TAB_COSD; tsn = TAB + TAB_SIND; stride = 8; }
        else { f = q - 72; inv = pow(500000.0, -(double)f / 16.0); tc = TAB + TAB_COSM; tsn = TAB + TAB_SINM; stride = 16; }
        for (int pos = p0; pos < SEQ; pos += P) { double sv, cv; sincos((double)pos * inv, &sv, &cv); tc[(size_t)pos * stride + f] = (float)cv; tsn[(size_t)pos * stride + f] = (float)sv; } } }
    bf16_t* XB = (bf16_t*)(KWS(a) + WS_XB); const float* x = KARG(a, 0);
    for (size_t i = gt; i < (size_t)NTOK * DM / 8; i += NT) { const f32x4 v0 = *(const f32x4*)(x + i * 8), v1 = *(const f32x4*)(x + i * 8 + 4);
        u32x4 o; o.x = cvtpk(v0[0], v0[1]); o.y = cvtpk(v0[2], v0[3]); o.z = cvtpk(v1[0], v1[1]); o.w = cvtpk(v1[2], v1[3]); *(u32x4*)(XB + i * 8) = o; }
}

__device__ __forceinline__ void rot8(u32x4& w1, u32x4& w2, const float* cs, const float* sn, float scale) {
    const f32x4 c0 = *(const f32x4*)cs, c1 = *(const f32x4*)(cs + 4), s0 = *(const f32x4*)sn, s1 = *(const f32x4*)(sn + 4);
    float a[8] = {bflo(w1.x), bfhi(w1.x), bflo(w1.y), bfhi(w1.y), bflo(w1.z), bfhi(w1.z), bflo(w1.w), bfhi(w1.w)};
    float b[8] = {bflo(w2.x), bfhi(w2.x), bflo(w2.y), bfhi(w2.y), bflo(w2.z), bfhi(w2.z), bflo(w2.w), bfhi(w2.w)};
    float cc[8] = {c0[0], c0[1], c0[2], c0[3], c1[0], c1[1], c1[2], c1[3]}, ss[8] = {s0[0], s0[1], s0[2], s0[3], s1[0], s1[1], s1[2], s1[3]};
    float ra[8], rb[8];
#pragma unroll
    for (int j = 0; j < 8; ++j) { ra[j] = (a[j] * cc[j] - b[j] * ss[j]) * scale; rb[j] = (b[j] * cc[j] + a[j] * ss[j]) * scale; }
    w1.x = cvtpk(ra[0], ra[1]); w1.y = cvtpk(ra[2], ra[3]); w1.z = cvtpk(ra[4], ra[5]); w1.w = cvtpk(ra[6], ra[7]);
    w2.x = cvtpk(rb[0], rb[1]); w2.y = cvtpk(rb[2], rb[3]); w2.z = cvtpk(rb[4], rb[5]); w2.w = cvtpk(rb[6], rb[7]);
}

__device__ __forceinline__ void p_rot0(const Args& a, int vcu, int G, int WV_) {
    const int tid = otid(), lane = tid & 63, wave = tid >> 6, gw = vcu * NWAVES + wave, NGW = G * NWAVES;
    bf16_t* Z = (bf16_t*)(KWS(a) + WS_Z); const float* TAB = (const float*)(KWS(a) + WS_TAB);
    const int tq = lane >> 5, h = (lane >> 3) & 3, i8 = lane & 7;
    const int drow = lane >> 4, dtq = (lane >> 3) & 1, dblk = lane & 7;
    for (int g = gw; g < NTOK / 4; g += NGW) { const int row0 = g * 4;
        u32x4 w1[5], w2[5]; bf16_t* p1[5];
#pragma unroll
        for (int i = 0; i < 4; ++i) { p1[i] = Z + (size_t)(row0 + i) * LDZ0 + tq * 512 + h * 128 + i8 * 8; w1[i] = *(u32x4*)p1[i]; w2[i] = *(u32x4*)(p1[i] + 64); }
        p1[4] = Z + (size_t)(row0 + drow) * LDZ0 + Z0_DQ + dtq * 512 + dblk * 64; w1[4] = *(u32x4*)p1[4]; w2[4] = *(u32x4*)(p1[4] + 8);
#pragma unroll
        for (int i = 0; i < 4; ++i) { const int pos = (row0 + i) & (SEQ - 1);
            rot8(w1[i], w2[i], TAB + TAB_COSR + (size_t)pos * 64 + i8 * 8, TAB + TAB_SINR + (size_t)pos * 64 + i8 * 8, tq ? 0.08838834764831845f : 1.f); }
        { const int pos = (row0 + drow) & (SEQ - 1); rot8(w1[4], w2[4], TAB + TAB_COSD + (size_t)pos * 8, TAB + TAB_SIND + (size_t)pos * 8, 1.f); }
#pragma unroll
        for (int i = 0; i < 4; ++i) { *(u32x4*)p1[i] = w1[i]; *(u32x4*)(p1[i] + 64) = w2[i]; }
        *(u32x4*)p1[4] = w1[4]; *(u32x4*)(p1[4] + 8) = w2[4];
    }
}

__device__ __forceinline__ void p_diffcomb(const Args& a, int vcu, int G, int WV_) {
    const int tid = otid(), lane = tid & 63, wave = tid >> 6, gw = vcu * NWAVES + wave, NGW = G * NWAVES;
    float s1 = KARG(a, 4)[lane] * KARG(a, 5)[lane], s2 = KARG(a, 6)[lane] * KARG(a, 7)[lane];
    s1 = wave_sum(s1); s2 = wave_sum(s2);
    const float lam_init = 0.2f;
    const float lam = (expf(s1) - expf(s2)) + lam_init;
    const float* OA = (const float*)(KWS(a) + WS_OAB); const float* OB = OA + (size_t)NTOK * 512; bf16_t* A2 = (bf16_t*)(KWS(a) + WS_A2);
    const float g0 = KARG(a, 8)[lane * 2], g1 = KARG(a, 8)[lane * 2 + 1];
    for (int t = gw; t < NTOK * 4; t += NGW) { const int row = t >> 2, h = t & 3; const size_t off = (size_t)row * 512 + h * 128 + lane * 2;
        const f32x2 va = *(const f32x2*)(OA + off), vb = *(const f32x2*)(OB + off);
        const float o0 = va[0] - lam * vb[0], o1 = va[1] - lam * vb[1];
        const float ms = wave_sum(o0 * o0 + o1 * o1) * (1.f / 128.f);
        const float rs = (1.f / sqrtf(ms + 1e-6f)) * (1.f - lam_init);
        *(unsigned*)(A2 + (size_t)row * 1024 + 512 + h * 128 + lane * 2) = cvtpk(o0 * rs * g0, o1 * rs * g1); }
}

__device__ __forceinline__ void unpack8(const u32x4 w, float* f) { f[0] = bflo(w.x); f[1] = bfhi(w.x); f[2] = bflo(w.y); f[3] = bfhi(w.y); f[4] = bflo(w.z); f[5] = bfhi(w.z); f[6] = bflo(w.w); f[7] = bfhi(w.w); }
__device__ __forceinline__ u32x4 pack8(const float* f) { u32x4 w; w.x = cvtpk(f[0], f[1]); w.y = cvtpk(f[2], f[3]); w.z = cvtpk(f[4], f[5]); w.w = cvtpk(f[6], f[7]); return w; }
__device__ __forceinline__ void ln_row16(float* v, const float* gv, const float* bv) {
    float s = 0.f;
#pragma unroll
    for (int i = 0; i < 16; ++i) s += v[i];
    const float mean = wave_sum(s) * (1.f / 1024.f); float q = 0.f;
#pragma unroll
    for (int i = 0; i < 16; ++i) { v[i] -= mean; q += v[i] * v[i]; }
    const float rstd = 1.f / sqrtf(wave_sum(q) * (1.f / 1024.f) + LN_EPS);
#pragma unroll
    for (int i = 0; i < 16; ++i) v[i] = v[i] * rstd * gv[i] + bv[i];
}
template <bool XF32>
__device__ __forceinline__ void p_ln1_router(const Args& a, char* lds, int vcu, int G, int layer, const void* xprev, int WV_) {
    const int tid = otid(), lane = tid & 63, wave = tid >> 6, gw = vcu * NWAVES + wave, NGW = G * NWAVES;
    const bf16_t* Yb = (const bf16_t*)(KWS(a) + WS_Y); bf16_t* XBp = (bf16_t*)(KWS(a) + WS_XB);
    const float* gam = KARG(a, 21) + layer * 1024; const float* bet = KARG(a, 22) + layer * 1024;
    const float* WR = (const float*)(KWS(a) + WS_WR) + (size_t)layer * 36 * 1024;
    unsigned* cnt = (unsigned*)(KWS(a) + WS_CNTB);
    int4* asg = (int4*)(KWS(a) + WS_ASG);
    LAS float* lg = (LAS float*)((LAS char*)lds + wave * 2048);
    LAS unsigned* lcnt = (LAS unsigned*)((LAS char*)lds + 16384);
    if (tid < 32) lcnt[tid] = 0u;
    __syncthreads();
    float gv[16], bv[16];
#pragma unroll
    for (int j = 0; j < 2; ++j)
#pragma unroll
        for (int q = 0; q < 2; ++q) { const f32x4 g4 = *(const f32x4*)(gam + 8 * lane + 512 * j + 4 * q), b4 = *(const f32x4*)(bet + 8 * lane + 512 * j + 4 * q);
#pragma unroll
            for (int e = 0; e < 4; ++e) { gv[j * 8 + q * 4 + e] = g4[e]; bv[j * 8 + q * 4 + e] = b4[e]; } }
    const int rbit = 4 * (lane & 1) + 2 * ((lane >> 1) & 1) + ((lane >> 2) & 1);
    for (int g8 = gw; g8 < NTOK / 8; g8 += NGW) {
        float xn[8][16];
#pragma unroll
        for (int half = 0; half < 2; ++half) {
            u32x4 yb[4][2];
#pragma unroll
            for (int r4 = 0; r4 < 4; ++r4) { const int rr = half * 4 + r4; const size_t ro = (size_t)(g8 * 8 + rr) * 1024 + 8 * lane;
#pragma unroll
                for (int j = 0; j < 2; ++j) {
                    if constexpr (XF32) { const f32x4 x0 = *(const f32x4*)((const float*)xprev + ro + 512 * j), x1 = *(const f32x4*)((const float*)xprev + ro + 512 * j + 4);
#pragma unroll
                        for (int e = 0; e < 4; ++e) { xn[rr][j * 8 + e] = x0[e]; xn[rr][j * 8 + 4 + e] = x1[e]; } }
                    else { const u32x4 xw = *(const u32x4*)((const bf16_t*)xprev + ro + 512 * j); unpack8(xw, &xn[rr][j * 8]); }
                    yb[r4][j] = *(const u32x4*)(Yb + ro + 512 * j); } }
#pragma unroll
            for (int r4 = 0; r4 < 4; ++r4) { const int rr = half * 4 + r4; const size_t ro = (size_t)(g8 * 8 + rr) * 1024 + 8 * lane;
#pragma unroll
                for (int j = 0; j < 2; ++j) { float yf[8]; unpack8(yb[r4][j], yf);
#pragma unroll
                    for (int e = 0; e < 8; ++e) xn[rr][j * 8 + e] = xn[rr][j * 8 + e] * ALPHA + yf[e]; }
                ln_row16(xn[rr], gv, bv);
#pragma unroll
                for (int j = 0; j < 2; ++j) *(u32x4*)(XBp + ro + 512 * j) = pack8(&xn[rr][j * 8]); }
        }
#define RT_LOAD(W, J) do { _Pragma("unroll") for (int j = 0; j < 4; ++j) W[j] = *(const f32x4*)(WR + (size_t)(J) * 1024 + 8 * lane + 512 * (j >> 1) + 4 * (j & 1)); } while (0)
#define RT_STEP(W, J) do { float ps[8]; \
            _Pragma("unroll") for (int rr = 0; rr < 8; ++rr) { float s = 0.f; \
                _Pragma("unroll") for (int j = 0; j < 4; ++j) _Pragma("unroll") for (int e = 0; e < 4; ++e) s = fmaf(xn[rr][j * 4 + e], W[j][e], s); \
                ps[rr] = s; } \
            float n1[4], n2[2]; \
            _Pragma("unroll") for (int i = 0; i < 4; ++i) { const float send = b0 ? ps[i] : ps[i + 4], keep = b0 ? ps[i + 4] : ps[i]; n1[i] = keep + __shfl_xor(send, 1); } \
            _Pragma("unroll") for (int i = 0; i < 2; ++i) { const float send = b1 ? n1[i] : n1[i + 2], keep = b1 ? n1[i + 2] : n1[i]; n2[i] = keep + __shfl_xor(send, 2); } \
            float tot; { const float send = b2 ? n2[0] : n2[1], keep = b2 ? n2[1] : n2[0]; tot = keep + __shfl_xor(send, 4); } \
            tot += __shfl_xor(tot, 8); tot += __shfl_xor(tot, 16); tot += __shfl_xor(tot, 32); \
            if (lane < 8) lg[rbit * 40 + (J)] = tot; } while (0)
        { const bool b0 = lane & 1, b1 = lane & 2, b2 = lane & 4;
          f32x4 wvA[4], wvB[4];
          RT_LOAD(wvA, 0);
          for (int jo = 0; jo < 36; jo += 2) {
              RT_LOAD(wvB, jo + 1);
              RT_STEP(wvA, jo);
              if (jo + 2 < 36) RT_LOAD(wvA, jo + 2);
              RT_STEP(wvB, jo + 1); } }
#undef RT_LOAD
#undef RT_STEP
        LDS_WAIT(); asm volatile("" ::: "memory");
        if (lane < 8) { const int row = g8 * 8 + lane; const LAS float* l = lg + lane * 40;
            float gl[4]; int gi = 0;
#pragma unroll
            for (int j = 0; j < 4; ++j) gl[j] = l[j] + KARG(a, 26)[layer * 4 + j];
            float gm = gl[0];
#pragma unroll
            for (int j = 1; j < 4; ++j) if (gl[j] > gm) { gm = gl[j]; gi = j; }
            float den = 0.f;
#pragma unroll
            for (int j = 0; j < 4; ++j) den += expf(gl[j] - gm);
            const float pg = 1.f / den;
            float l1 = -3.0e38f, l2 = -3.0e38f; int i1 = 0, i2 = 0;
            for (int j = 0; j < 8; ++j) { const float v = l[4 + gi * 8 + j] + KARG(a, 28)[layer * 32 + gi * 8 + j];
                if (v > l1) { l2 = l1; i2 = i1; l1 = v; i1 = j; } else if (v > l2) { l2 = v; i2 = j; } }
            const float e2 = expf(l2 - l1), w1 = 1.f / (1.f + e2), w2 = e2 * w1;
            const int e1i = gi * 8 + i1, e2i = gi * 8 + i2;
            const unsigned sl1 = __hip_atomic_fetch_add(lcnt + e1i, 1u, __ATOMIC_RELAXED, __HIP_MEMORY_SCOPE_WORKGROUP), sl2 = __hip_atomic_fetch_add(lcnt + e2i, 1u, __ATOMIC_RELAXED, __HIP_MEMORY_SCOPE_WORKGROUP);
            asg[row * 2 + 0] = make_int4(e1i, (int)sl1, __float_as_int(pg * w1), (int)blockIdx.x);
            asg[row * 2 + 1] = make_int4(e2i, (int)sl2, __float_as_int(pg * w2), (int)blockIdx.x); }
        LDS_WAIT(); asm volatile("" ::: "memory");
    }
    __syncthreads();
    if (tid < 32) cnt[(size_t)blockIdx.x * 32 + tid] = lcnt[tid];
}

__device__ __forceinline__ void p_moe_scatter(const Args& a, char* lds, int vcu, int G, int layer, int WV_) {
    const int tid = otid(), lane = tid & 63, wave = tid >> 6, gw = vcu * NWAVES + wave, NGW = G * NWAVES;
    const unsigned* cntb = (const unsigned*)(KWS(a) + WS_CNTB);
    LAS int* off = (LAS int*)((LAS char*)lds);
    LAS unsigned short* pb = (LAS unsigned short*)((LAS char*)lds + 1024);
    {
        const int e = tid >> 4, s = tid & 15; unsigned c[16]; unsigned run = 0;
#pragma unroll
        for (int i = 0; i < 16; ++i) { const int b = s * 16 + i; c[i] = (b < G) ? cntb[(size_t)b * 32 + e] : 0u; }
        LAS unsigned* seg = (LAS unsigned*)((LAS char*)lds + 20480);
#pragma unroll
        for (int i = 0; i < 16; ++i) run += c[i];
        seg[e * 16 + s] = run;
        __syncthreads();
        unsigned base = 0; for (int q = 0; q < s; ++q) base += seg[e * 16 + q];
#pragma unroll
        for (int i = 0; i < 16; ++i) { const int b = s * 16 + i; if (b < G) pb[b * 32 + e] = (unsigned short)base; base += c[i]; }
        if (s == 15) off[40 + e] = (int)base;
        __syncthreads();
        if (tid == 0) { int o = 0; for (int q = 0; q < 32; ++q) { off[q] = o; o += (off[40 + q] + 255) & ~255; } off[32] = o; }
        __syncthreads();
    }
    const int4* asg = (const int4*)(KWS(a) + WS_ASG); int2* rowinfo = (int2*)(KWS(a) + WS_ROWINFO); int* tiles = (int*)(KWS(a) + WS_TILES);
    for (int as = vcu * 512 + tid; as < NTOK * 2; as += G * 512) { const int4 q = asg[as]; const int dest = off[q.x] + (int)pb[q.w * 32 + q.x] + q.y; rowinfo[dest] = make_int2(as, q.z); }
    if (blockIdx.x < 32) { const int e = blockIdx.x; const int c = off[40 + e];
        for (int r = off[e] + c + tid; r < off[e + 1]; r += 512) rowinfo[r] = make_int2(-1, 0); }
    if (blockIdx.x == 32 && tid < 64) { const int nt = off[32] >> 8; if (tid == 0) tiles[0] = nt;
        for (int t = tid; t < nt; t += 64) { int e = 0; for (int jj = 1; jj < 32; ++jj) if (off[jj] <= t * 256) e = jj; tiles[1 + t] = e; } }
    __syncthreads();
}

template <bool FINAL>
__device__ __forceinline__ void p_ln2(const Args& a, int vcu, int G, int layer, float* xout, int WV_) {
    const int tid = otid(), lane = tid & 63, wave = tid >> 6, gw = vcu * NWAVES + wave, NGW = G * NWAVES;
    const bf16_t* YS = (const bf16_t*)(KWS(a) + WS_YS); bf16_t* XBp = (bf16_t*)(KWS(a) + WS_XB);
    const float* gam = KARG(a, 23) + layer * 1024; const float* bet = KARG(a, 24) + layer * 1024;
    float gv[16], bv[16];
#pragma unroll
    for (int j = 0; j < 2; ++j)
#pragma unroll
        for (int q = 0; q < 2; ++q) { const f32x4 g4 = *(const f32x4*)(gam + 8 * lane + 512 * j + 4 * q), b4 = *(const f32x4*)(bet + 8 * lane + 512 * j + 4 * q);
#pragma unroll
            for (int e = 0; e < 4; ++e) { gv[j * 8 + q * 4 + e] = g4[e]; bv[j * 8 + q * 4 + e] = b4[e]; } }
    for (int g8 = gw; g8 < NTOK / 4; g8 += NGW) {
        u32x4 xw[4][2], y0[4][2], y1[4][2];
#pragma unroll
        for (int rr = 0; rr < 4; ++rr) { const size_t ro = (size_t)(g8 * 4 + rr) * 1024 + 8 * lane;
#pragma unroll
            for (int j = 0; j < 2; ++j) { xw[rr][j] = *(const u32x4*)(XBp + ro + 512 * j); y0[rr][j] = *(const u32x4*)(YS + ro + 512 * j); y1[rr][j] = *(const u32x4*)(YS + (size_t)NTOK * 1024 + ro + 512 * j); } }
#pragma unroll
        for (int rr = 0; rr < 4; ++rr) { const size_t ro = (size_t)(g8 * 4 + rr) * 1024 + 8 * lane; float v[16];
#pragma unroll
            for (int j = 0; j < 2; ++j) { float xf[8], a0[8], a1[8]; unpack8(xw[rr][j], xf); unpack8(y0[rr][j], a0); unpack8(y1[rr][j], a1);
#pragma unroll
                for (int e = 0; e < 8; ++e) v[j * 8 + e] = xf[e] * ALPHA + (a0[e] + a1[e]); }
            ln_row16(v, gv, bv);
#pragma unroll
            for (int j = 0; j < 2; ++j) {
                if constexpr (FINAL) { *(f32x4*)(xout + ro + 512 * j) = (f32x4){v[j * 8], v[j * 8 + 1], v[j * 8 + 2], v[j * 8 + 3]}; *(f32x4*)(xout + ro + 512 * j + 4) = (f32x4){v[j * 8 + 4], v[j * 8 + 5], v[j * 8 + 6], v[j * 8 + 7]}; }
                else *(u32x4*)(XBp + ro + 512 * j) = pack8(&v[j * 8]); } }
    }
}

__device__ __forceinline__ void p_front1(const Args& a, int vcu, int G, int WV_) {
    const int tid = otid(), lane = tid & 63, wave = tid >> 6, gw = vcu * NWAVES + wave, NGW = G * NWAVES;
    const bf16_t* Z = (const bf16_t*)(KWS(a) + WS_Z); bf16_t* MK = (bf16_t*)(KWS(a) + WS_MK); const float* TAB = (const float*)(KWS(a) + WS_TAB);
    for (int g = gw; g * 32 < NTOK; g += NGW) { const int row = g * 32 + (lane >> 1), i8 = lane & 1, pos = row & (SEQ - 1);
        const bf16_t* p1 = Z + (size_t)row * LDZ1 + Z1_KR + i8 * 8;
        u32x4 w1 = *(const u32x4*)p1, w2 = *(const u32x4*)(p1 + 16);
        rot8(w1, w2, TAB + TAB_COSM + (size_t)pos * 16 + i8 * 8, TAB + TAB_SINM + (size_t)pos * 16 + i8 * 8, 1.f);
        u32x4 lo, hi2;
        lo.x = (w1.x & 0xffffu) | (w2.x << 16); lo.y = (w1.x >> 16) | (w2.x & 0xffff0000u); lo.z = (w1.y & 0xffffu) | (w2.y << 16); lo.w = (w1.y >> 16) | (w2.y & 0xffff0000u);
        hi2.x = (w1.z & 0xffffu) | (w2.z << 16); hi2.y = (w1.z >> 16) | (w2.z & 0xffff0000u); hi2.z = (w1.w & 0xffffu) | (w2.w << 16); hi2.w = (w1.w >> 16) | (w2.w & 0xffff0000u);
#pragma unroll
        for (int h = 0; h < 4; ++h) { bf16_t* d = MK + (size_t)row * 512 + h * 128 + 64 + 16 * i8; *(u32x4*)d = lo; *(u32x4*)(d + 8) = hi2; } }
    float* BF = (float*)(KWS(a) + WS_BF); float* BB = (float*)(KWS(a) + WS_BB);
    const int dir = tid >> 8, j = tid & 255;
    const float* w2p = dir ? KARG(a, 17) : KARG(a, 15); const float bias = (dir ? KARG(a, 18) : KARG(a, 16))[j];
    float wv[16];
#pragma unroll
    for (int i = 0; i < 16; ++i) wv[i] = w2p[i * 256 + j];
    float* Bo = dir ? BB : BF;
    const bool split = (G == 256); const int u0 = split ? (int)blockIdx.x - 128 : vcu, ustep = split ? 128 : G;
    for (int u = u0; u >= 0 && u < 256; u += ustep) { const long rb = (long)(u >> 7) * SEQ + (long)(u & 127) * 64; float run = 0.f;
        for (int s0 = 0; s0 < 64; s0 += 8) { u32x4 l0[8], l1[8];
#pragma unroll
            for (int i = 0; i < 8; ++i) { const long row = rb + (dir ? 63 - (s0 + i) : (s0 + i)); l0[i] = *(const u32x4*)(Z + (size_t)row * LDZ1 + Z1_LRF + dir * 16); l1[i] = *(const u32x4*)(Z + (size_t)row * LDZ1 + Z1_LRF + dir * 16 + 8); }
#pragma unroll
            for (int i = 0; i < 8; ++i) { const long row = rb + (dir ? 63 - (s0 + i) : (s0 + i));
                float z = bias;
                z += bflo(l0[i].x) * wv[0] + bfhi(l0[i].x) * wv[1] + bflo(l0[i].y) * wv[2] + bfhi(l0[i].y) * wv[3] + bflo(l0[i].z) * wv[4] + bfhi(l0[i].z) * wv[5] + bflo(l0[i].w) * wv[6] + bfhi(l0[i].w) * wv[7];
                z += bflo(l1[i].x) * wv[8] + bfhi(l1[i].x) * wv[9] + bflo(l1[i].y) * wv[10] + bfhi(l1[i].y) * wv[11] + bflo(l1[i].z) * wv[12] + bfhi(l1[i].z) * wv[13] + bflo(l1[i].w) * wv[14] + bfhi(l1[i].w) * wv[15];
                const float ls = fminf(z, 0.f) - __logf(1.f + __expf(-fabsf(z)));
                run += ls * (1.f / 16.f);
                Bo[(size_t)row * 256 + j] = run; } } }
}

constexpr int NPHASE = 28;
__global__ void __launch_bounds__(NWAVES * 64, 2) mega_fwd(Args args) {
    extern __shared__ __attribute__((aligned(16))) unsigned char lds_raw[];
    char* lds = (char*)lds_raw; LAS unsigned char* ldsl = (LAS unsigned char*)lds_raw;
    const int WV_ = __builtin_amdgcn_readfirstlane((int)threadIdx.x >> 6);
    const int tid = otid();
    const int G = gridDim.x; const int bx = blockIdx.x; const int vcu = (G % 8 == 0) ? (bx % 8) * (G / 8) + bx / 8 : bx;
    volatile LAS unsigned* MISC = (volatile LAS unsigned*)(ldsl + MISC_OFF);
    for (int u = tid; u < (LDS_BYTES - RING_BYTES) / 4; u += NWAVES * 64) ((LAS unsigned*)(ldsl + RING_BYTES))[u] = 0u;
    __syncthreads();
#define ws KWS(args)
    unsigned* ctl = (unsigned*)(ws + WS_CTL);
    const int lo = args.ph_lo, hi = args.ph_hi;
    const bool use_bar = (hi - lo) > 1;
    XcdBarrier bar; bar.bar = ctl + CW_BAR; bar.x = 0; bar.st = nullptr;
    if (use_bar) bar = xcd_barrier_post(ctl + CW_BAR, MISC + 8, WV_);
#define IN(k) (lo <= (k) && (k) < hi)
#define SEAM(k) do { if (IN(k) && IN((k) + 1)) xcd_barrier(bar, WV_); } while (0)
#define XB ((bf16_t*)(ws + WS_XB))
#define ZBUF ((bf16_t*)(ws + WS_Z))
#define A2 ((bf16_t*)(ws + WS_A2))
#define X1F ((float*)(ws + WS_X1F))
#define Y ((float*)(ws + WS_Y))

    if (IN(0)) { p_prologue(args, lds, vcu, G, WV_); } SEAM(0);
    if (IN(1)) { pg8::Gemm g{XB, (const bf16_t*)(ws + WS_WIN0), 1024, 1024, 1024}; pg8::StaticOrder S; S.init(NTOK, LDZ0, G, bx);
        pg8::EpiBf16 E{ZBUF, LDZ0, 0, 0}; pg8::gemm_phase<pg8::EpiBf16, pg8::StaticOrder, true>(ldsl, g, S, E, WV_); } SEAM(1);
    if (IN(2)) { p_rot0(args, vcu, G, WV_); } SEAM(2);
    {
        chk::Cfg cf; cf.Z = ZBUF; cf.ld = LDZ0; cf.qcol = Z0_RQ; cf.kcol = Z0_RK; cf.vcol = Z0_RV; cf.gcol = Z0_RG; cf.BF = nullptr; cf.BB = nullptr;
        cf.dec_f = KARG(args, 2); cf.dec_b = KARG(args, 3); cf.qscale = 1.f; cf.U = (bf16_t*)(ws + WS_U); cf.OUT = A2; cf.ldo = 1024; cf.ocol = 0; cf.gain = nullptr;
        if (IN(3)) { for (int u = vcu; u < 256; u += G) chk::chunk_states<128, true>(cf, lds, u, WV_); } SEAM(3);
        if (IN(4)) { chk::chunk_scan<128, true>(cf, bx * 512 + tid); } SEAM(4);
        if (IN(5)) { for (int u = vcu; u < 256; u += G) chk::chunk_out<128, true>(cf, lds, u, WV_); } SEAM(5);
    }
    if (IN(6)) { float* OAB = (float*)(ws + WS_OAB);
        const int ln = tid & 63; float s1 = KARG(args, 4)[ln] * KARG(args, 5)[ln], s2 = KARG(args, 6)[ln] * KARG(args, 7)[ln]; s1 = wave_sum(s1); s2 = wave_sum(s2);
        const float lam = (expf(s1) - expf(s2)) + 0.2f;
        for (int u = vcu; u < 256; u += G) { const int bh = u >> 5, qb = u & 31, h = bh & 3, b = bh >> 2;
            const size_t r0 = (size_t)b * SEQ; const bf16_t* Qp = ZBUF + (r0 + qb * 256) * LDZ0 + Z0_DQ + h * 128; const bf16_t* Kp = ZBUF + r0 * LDZ0 + Z0_DK + h * 128; const bf16_t* Vp = ZBUF + r0 * LDZ0 + Z0_DV + h * 128;
            float* Op = OAB + (r0 + qb * 256) * 512 + h * 128;
            att::attn_dense_body<0, 4, float>(Qp, LDZ0, Kp, LDZ0, Vp, LDZ0, Op, 512, SEQ, 0.125f, lds, WV_);
            att::attn_dense_body<4, 8, bf16_t, true>(Qp, LDZ0, Kp, LDZ0, Vp, LDZ0, A2 + (r0 + qb * 256) * 1024 + 512 + h * 128, 1024, SEQ, 0.125f, lds, WV_, Op, 512, lam, KARG(args, 8)); } } SEAM(6);
    if (IN(8)) { pg8::Gemm g{A2, (const bf16_t*)(ws + WS_WOUT0), 1024, 1024, 1024}; pg8::StaticOrder S; S.init(NTOK, 1024, G, bx);
        pg8::EpiBf16 E{(bf16_t*)Y, 1024, 0, 0}; pg8::gemm_phase<pg8::EpiBf16, pg8::StaticOrder, true>(ldsl, g, S, E, WV_); } SEAM(8);
    if (IN(9)) { p_ln1_router<false>(args, lds, vcu, G, 0, XB, WV_); } SEAM(9);
    if (IN(10)) { p_moe_scatter(args, lds, vcu, G, 0, WV_); } SEAM(10);
    if (IN(11)) { pg8::Gemm g{XB, (const bf16_t*)(ws + WS_WGU), 1024, 1024, 1024}; pg8::MoeOrder S{(const int*)(ws + WS_TILES), G, vcu, 1024};
        pg8::EpiGU E{(bf16_t*)(ws + WS_H), 512}; pg8::gemm_phase<pg8::EpiGU, pg8::MoeOrder, true, true>(ldsl, g, S, E, WV_, (const int2*)(ws + WS_ROWINFO)); } SEAM(11);
    if (IN(12)) { pg8::Gemm g{(const bf16_t*)(ws + WS_H), (const bf16_t*)(ws + WS_WDN), 512, 512, 512}; pg8::MoeOrder S{(const int*)(ws + WS_TILES), G, vcu, 1024};
        pg8::EpiDown E{(bf16_t*)(ws + WS_YS), (const int2*)(ws + WS_ROWINFO)}; pg8::gemm_phase<pg8::EpiDown, pg8::MoeOrder, true>(ldsl, g, S, E, WV_); } SEAM(12);
    if (IN(13)) { p_ln2<false>(args, vcu, G, 0, nullptr, WV_);
        { const int lane = tid & 63, wave = tid >> 6; LAS float* scr = (LAS float*)((LAS char*)lds + wave * 16384);
          for (int it = vcu * NWAVES + wave; it < 32 * 768; it += G * NWAVES) moe_weight_item(args, 1, it, scr, lane); } } SEAM(13);
    if (IN(14)) { pg8::Gemm g{XB, (const bf16_t*)(ws + WS_WIN1), 1024, 1024, 1024}; pg8::StaticOrder S; S.init(NTOK, LDZ1, G, bx);
        pg8::EpiBf16 E{ZBUF, LDZ1, 0, 0}; pg8::gemm_phase<pg8::EpiBf16, pg8::StaticOrder, true>(ldsl, g, S, E, WV_); } SEAM(14);
    if (IN(15)) { p_front1(args, vcu, G, WV_);
        const float* TABp = (const float*)(ws + WS_TAB);
        { pg8::Gemm g{ZBUF + Z1_CQ, (const bf16_t*)(ws + WS_WUQ), LDZ1, 256, 256}; pg8::StaticOrder S; S.init(NTOK, 512, G, bx);
          pg8::EpiNormUp<0, true, false> E{(bf16_t*)(ws + WS_MQ), 512, 0, 0, nullptr, 0, TABp + TAB_COSM, TABp + TAB_SINM}; pg8::gemm_phase<pg8::EpiNormUp<0, true, false>, pg8::StaticOrder, true>(ldsl, g, S, E, WV_); }
        { pg8::Gemm g{ZBUF + Z1_CKV, (const bf16_t*)(ws + WS_WUKV), LDZ1, 256, 256}; pg8::StaticOrder S; S.init(NTOK, 1024, G, bx);
          pg8::EpiNormUp<128, false, true> E{(bf16_t*)(ws + WS_MK), 512, 512, (size_t)(WS_MV - WS_MK) / 2, ZBUF + Z1_CKV, LDZ1, nullptr, nullptr}; pg8::gemm_phase<pg8::EpiNormUp<128, false, true>, pg8::StaticOrder, true>(ldsl, g, S, E, WV_); }
    } SEAM(15);
    if (IN(18)) { const bf16_t* MQ = (const bf16_t*)(ws + WS_MQ); const bf16_t* MK = (const bf16_t*)(ws + WS_MK); const bf16_t* MV = (const bf16_t*)(ws + WS_MV);
        for (int u = vcu; u < 256; u += G) { const int bh = u >> 5, qb = u & 31, h = bh & 3, b = bh >> 2; const size_t r0 = (size_t)b * SEQ;
            att::attn_dense_body<0, 6, bf16_t>(MQ + (r0 + qb * 256) * 512 + h * 128, 512, MK + r0 * 512 + h * 128, 512, MV + r0 * 512 + h * 128, 512,
                                               A2 + (r0 + qb * 256) * 1024 + h * 128, 1024, SEQ, 0.10206207261596577f, lds, WV_, nullptr, 0, 0.f, nullptr, ZBUF + (r0 + qb * 256) * LDZ1 + Z1_CQ, LDZ1); } } SEAM(18);
    {
        chk::Cfg cf; cf.Z = ZBUF; cf.ld = LDZ1; cf.qcol = Z1_GQ; cf.kcol = Z1_GK; cf.vcol = Z1_GV; cf.gcol = Z1_GG; cf.BF = (const float*)(ws + WS_BF); cf.BB = (const float*)(ws + WS_BB);
        cf.dec_f = nullptr; cf.dec_b = nullptr; cf.qscale = 0.125f; cf.U = (bf16_t*)(ws + WS_U); cf.OUT = A2; cf.ldo = 1024; cf.ocol = 512; cf.gain = KARG(args, 19);
        if (IN(19)) { for (int u = vcu; u < 256; u += G) chk::chunk_states<64, false>(cf, lds, u, WV_); } SEAM(19);
        if (IN(20)) { if (tid < 256) chk::chunk_scan<64, false>(cf, bx * 256 + tid); } SEAM(20);
        if (IN(21)) { for (int u = vcu; u < 256; u += G) chk::chunk_out<64, false>(cf, lds, u, WV_); } SEAM(21);
    }
    if (IN(22)) { pg8::Gemm g{A2, (const bf16_t*)(ws + WS_WOUT1), 1024, 1024, 1024}; pg8::StaticOrder S; S.init(NTOK, 1024, G, bx);
        pg8::EpiBf16 E{(bf16_t*)Y, 1024, 0, 0}; pg8::gemm_phase<pg8::EpiBf16, pg8::StaticOrder, true>(ldsl, g, S, E, WV_); } SEAM(22);
    if (IN(23)) { p_ln1_router<false>(args, lds, vcu, G, 1, XB, WV_); } SEAM(23);
    if (IN(24)) { p_moe_scatter(args, lds, vcu, G, 1, WV_); } SEAM(24);
    if (IN(25)) { pg8::Gemm g{XB, (const bf16_t*)(ws + WS_WGU), 1024, 1024, 1024}; pg8::MoeOrder S{(const int*)(ws + WS_TILES), G, vcu, 1024};
        pg8::EpiGU E{(bf16_t*)(ws + WS_H), 512}; pg8::gemm_phase<pg8::EpiGU, pg8::MoeOrder, true, true>(ldsl, g, S, E, WV_, (const int2*)(ws + WS_ROWINFO)); } SEAM(25);
    if (IN(26)) { pg8::Gemm g{(const bf16_t*)(ws + WS_H), (const bf16_t*)(ws + WS_WDN), 512, 512, 512}; pg8::MoeOrder S{(const int*)(ws + WS_TILES), G, vcu, 1024};
        pg8::EpiDown E{(bf16_t*)(ws + WS_YS), (const int2*)(ws + WS_ROWINFO)}; pg8::gemm_phase<pg8::EpiDown, pg8::MoeOrder, true>(ldsl, g, S, E, WV_); } SEAM(26);
    if (IN(27)) { p_ln2<true>(args, vcu, G, 1, KOUT(args), WV_); }
#undef IN
#undef SEAM
#undef ws
#undef XB
#undef ZBUF
#undef A2
#undef X1F
#undef Y
}

#ifndef DBG_STOP
#define DBG_STOP -1
#endif
__global__ void dbg_dump(const void* src, int is_bf16, float* out, size_t n, int sanitize_only) {
    for (size_t i = (size_t)blockIdx.x * blockDim.x + threadIdx.x; i < n; i += (size_t)gridDim.x * blockDim.x) {
        float v = (sanitize_only == 1) ? out[i] : (is_bf16 ? bf1(((const bf16_t*)src)[i]) : ((const float*)src)[i]);
        if (!(fabsf(v) < 1e30f)) v = 777.f;
        if (sanitize_only == 2 && (i & 1023) >= 512) v = 0.f;
        if (sanitize_only == 3 && (i & 1023) < 512) v = 0.f;
        out[i] = v; }
}
#ifndef MK_SPLIT
#define MK_SPLIT 0
#endif
extern "C" void kernel_launch(void* const* d_in, const int* in_sizes, int n_in, void* d_out, int out_size, void* d_ws, size_t ws_size, hipStream_t stream) {
    static int grid = 0;
    if (grid == 0) {
        if (n_in != 32 || out_size != NTOK * DM || ws_size < WS_END) { fprintf(stderr, "kernel_launch: unexpected shapes (n_in %d, out %d, ws %zu < %zu)\n", n_in, out_size, ws_size, (size_t)WS_END); grid = -1; return; }
        int dev = 0, cus = 0, per_cu = 0;
        if (hipGetDevice(&dev) != hipSuccess || hipDeviceGetAttribute(&cus, hipDeviceAttributeMultiprocessorCount, dev) != hipSuccess) { grid = -1; return; }
        if (hipFuncSetAttribute((const void*)mega_fwd, hipFuncAttributeMaxDynamicSharedMemorySize, LDS_BYTES) != hipSuccess) { fprintf(stderr, "kernel_launch: hipFuncSetAttribute failed\n"); grid = -1; return; }
        if (hipOccupancyMaxActiveBlocksPerMultiprocessor(&per_cu, (const void*)mega_fwd, NWAVES * 64, LDS_BYTES) != hipSuccess || per_cu < 1)
            fprintf(stderr, "kernel_launch: occupancy query reports %d\n", per_cu);
        (void)hipGetLastError();
        grid = cus;
    }
    if (grid < 0) return;
    (void)hipMemsetAsync((char*)d_ws + WS_CTL, 0, CTL_ZERO_BYTES, stream);
    Args a{};
    for (int i = 0; i < 32; ++i) a.in[i] = (const float*)d_in[i];
    a.out = (float*)d_out; a.ws = (unsigned char*)d_ws;
#if MK_SPLIT
    const int plast = (DBG_STOP >= 0) ? DBG_STOP : NPHASE - 1;
    for (int p = 0; p <= plast; ++p) { a.ph_lo = p; a.ph_hi = p + 1; hipLaunchKernelGGL(mega_fwd, dim3(grid), dim3(NWAVES * 64), LDS_BYTES, stream, a); }
    if (DBG_STOP >= 0) {
        const void* srcp = nullptr; int isb = 0, sano = 0;
        switch (DBG_STOP) {
            case 1: case 2: srcp = (char*)d_ws + WS_Z; isb = 1; break;
            case 5: case 18: srcp = (char*)d_ws + WS_A2; isb = 1; sano = 2; break;
            case 7: case 21: srcp = (char*)d_ws + WS_A2; isb = 1; sano = 3; break;
            case 3: case 4: case 19: case 20: srcp = (char*)d_ws + WS_U; isb = 1; break;
            case 6: srcp = (char*)d_ws + WS_OAB; isb = 0; break;
            case 8: case 22: srcp = (char*)d_ws + WS_Y; isb = 0; break;
            case 9: case 23: srcp = (char*)d_ws + WS_X1F; isb = 0; break;
            case 12: case 26: srcp = (char*)d_ws + WS_YS; isb = 1; break;
            case 14: case 16: srcp = (char*)d_ws + WS_Z; isb = 1; break;
            default: sano = 1; break;
        }
        hipLaunchKernelGGL(dbg_dump, dim3(2048), dim3(256), 0, stream, srcp, isb, (float*)d_out, (size_t)NTOK * DM, sano);
    }
#else
#ifdef PROBE_REP
    a.ph_lo = 0; a.ph_hi = PROBE_REP_HI; hipLaunchKernelGGL(mega_fwd, dim3(grid), dim3(NWAVES * 64), LDS_BYTES, stream, a);
    if (PROBE_REP == 9 || PROBE_REP == 23) (void)hipMemsetAsync((char*)d_ws + WS_CTL + CW_CNT0 * 4, 0, 512, stream);
    for (int r = 0; r < PROBE_REP_N; ++r) for (int p = PROBE_REP; p < PROBE_REP_HI; ++p) { a.ph_lo = p; a.ph_hi = p + 1; hipLaunchKernelGGL(mega_fwd, dim3(grid), dim3(NWAVES * 64), LDS_BYTES, stream, a); }
    if (PROBE_REP_HI < NPHASE) { (void)hipMemsetAsync((char*)d_ws + WS_CTL + CW_BAR * 4, 0, XCD_BAR_WORDS * 4, stream); a.ph_lo = PROBE_REP_HI; a.ph_hi = NPHASE; hipLaunchKernelGGL(mega_fwd, dim3(grid), dim3(NWAVES * 64), LDS_BYTES, stream, a); }
#else
    a.ph_lo = 0; a.ph_hi = NPHASE; hipLaunchKernelGGL(mega_fwd, dim3(grid), dim3(NWAVES * 64), LDS_BYTES, stream, a);
#endif
#endif
}
```

```cpp
#include <hip/hip_runtime.h>
#include <cstdio>
#include <cstdint>

#define LAS __attribute__((address_space(3)))
typedef unsigned short bf16_t;
typedef short bf16x8 __attribute__((ext_vector_type(8)));
typedef short s16x4 __attribute__((ext_vector_type(4)));
typedef short v4i16_t __attribute__((ext_vector_type(4)));
typedef float f32x2 __attribute__((ext_vector_type(2)));
typedef float f32x4 __attribute__((ext_vector_type(4)));
typedef float f32x16 __attribute__((ext_vector_type(16)));
typedef unsigned u32x2 __attribute__((ext_vector_type(2)));
typedef int i32x2 __attribute__((ext_vector_type(2)));
typedef unsigned u32x4 __attribute__((ext_vector_type(4)));

constexpr int NTOK = 16384, SEQ = 8192, DM = 1024, NCHUNK = 128;
constexpr int LDZ0 = 3584, LDZ1 = 2048;
constexpr int Z0_RQ = 0, Z0_RK = 512, Z0_RV = 1024, Z0_RG = 1536, Z0_DQ = 2048, Z0_DK = 2560, Z0_DV = 3072;
constexpr int Z1_CQ = 0, Z1_CKV = 256, Z1_KR = 384, Z1_GQ = 416, Z1_GK = 672, Z1_GV = 928, Z1_GG = 1440, Z1_LRF = 1952, Z1_LRB = 1968;
constexpr float ALPHA = 1.4142135623730951f;
constexpr float LN_EPS = 1e-5f;
constexpr int MOE_CAP = 32768 + 32 * 256;
constexpr int MAX_TILES = MOE_CAP / 256;

constexpr size_t MiB = 1u << 20;
constexpr size_t WS_CTL = 0, CTL_ZERO_BYTES = 64 * 1024;
constexpr size_t WS_TAB = 1 * MiB;
constexpr size_t WS_WR = 7 * MiB;
constexpr size_t WS_WUQ = 7 * MiB + 512 * 1024;
constexpr size_t WS_WUKV = 8 * MiB;
constexpr size_t WS_WIN0 = 9 * MiB;
constexpr size_t WS_WOUT0 = 16 * MiB;
constexpr size_t WS_WIN1 = 18 * MiB;
constexpr size_t WS_WOUT1 = 22 * MiB;
constexpr size_t WS_WGU = 24 * MiB;
constexpr size_t WS_WDN = 88 * MiB;
constexpr size_t WS_X1F = 120 * MiB;
constexpr size_t WS_XB = 184 * MiB;
constexpr size_t WS_A2 = 216 * MiB;
constexpr size_t WS_ASG = 248 * MiB;
constexpr size_t WS_ROWINFO = 249 * MiB;
constexpr size_t WS_TILES = 250 * MiB;
constexpr size_t WS_CNTB = 251 * MiB;
constexpr size_t WS_S = 252 * MiB;
constexpr size_t WS_Z = WS_S;
constexpr size_t WS_U = WS_S + 112 * MiB;
constexpr size_t WS_OAB = WS_S + 176 * MiB;
constexpr size_t WS_MQ = WS_S + 64 * MiB;
constexpr size_t WS_MK = WS_S + 80 * MiB;
constexpr size_t WS_MV = WS_S + 96 * MiB;
constexpr size_t WS_AQ = WS_S + 176 * MiB;
constexpr size_t WS_AKV = WS_S + 184 * MiB;
constexpr size_t WS_BF = WS_S + 192 * MiB;
constexpr size_t WS_BB = WS_S + 208 * MiB;
constexpr size_t WS_Y = WS_S;
constexpr size_t WS_XS = WS_S + 64 * MiB;
constexpr size_t WS_H = WS_S + 144 * MiB;
constexpr size_t WS_YS = WS_S + 184 * MiB;
constexpr size_t WS_END = WS_S + 256 * MiB;
constexpr size_t TAB_COSR = 0, TAB_SINR = 8192 * 64, TAB_COSD = 2 * 8192 * 64, TAB_SIND = TAB_COSD + 8192 * 8, TAB_COSM = TAB_SIND + 8192 * 8, TAB_SINM = TAB_COSM + 8192 * 16;
constexpr int CW_BAR = 1024;
constexpr int CW_CNT0 = 8192, CW_CNT1 = 8192 + 64;

typedef __bf16 bf16x2_t __attribute__((ext_vector_type(2)));
__device__ __forceinline__ unsigned cvtpk_asm(float lo, float hi) { unsigned r; asm volatile("v_cvt_pk_bf16_f32 %0, %1, %2" : "=v"(r) : "v"(lo), "v"(hi)); return r; }
__device__ __forceinline__ unsigned cvtpk(float lo, float hi) { f32x2 v = {lo, hi}; bf16x2_t b = __builtin_convertvector(v, bf16x2_t); return __builtin_bit_cast(unsigned, b); }
__device__ __forceinline__ float bflo(unsigned w) { return __uint_as_float(w << 16); }
__device__ __forceinline__ float bfhi(unsigned w) { return __uint_as_float(w & 0xffff0000u); }
__device__ __forceinline__ float bf1(bf16_t b) { return __uint_as_float(((unsigned)b) << 16); }
__device__ __forceinline__ bf16_t f2bf(float f) { return (bf16_t)(cvtpk(f, 0.f) & 0xffffu); }
__device__ __forceinline__ float wave_sum(float v) {
#pragma unroll
    for (int o = 1; o < 64; o <<= 1) v += __shfl_xor(v, o);
    return v;
}
__device__ __forceinline__ float half_sum(float v) {
#pragma unroll
    for (int o = 1; o < 32; o <<= 1) v += __shfl_xor(v, o);
    return v;
}
__device__ __forceinline__ float silu_f(float x) { return x * __builtin_amdgcn_rcpf(1.f + __expf(-x)); }
__device__ __forceinline__ int otid_(int wv) { unsigned l; asm volatile("v_mbcnt_lo_u32_b32 %0, -1, 0\n\tv_mbcnt_hi_u32_b32 %0, -1, %0" : "=v"(l)); return (wv << 6) | (int)l; }
#define otid() otid_(WV_)
#define LDS_WAIT() asm volatile("s_waitcnt lgkmcnt(0)" ::: "memory")
#define VM_WAIT() asm volatile("s_waitcnt vmcnt(0)" ::: "memory")

namespace pg8 {
constexpr int BM = 256, BK = 64, HALF = 128, HTB = HALF * BK * 2, STAGE_BYTES = 8 * HTB, NXCD = 8, WGM = 8;
__host__ __device__ __forceinline__ int lds_byte(int r, int c) { const int st = (r >> 4) * 2 + (c >> 5), rr = r & 15, cc = c & 31, ob = rr * 64 + cc * 2; return st * 1024 + (ob ^ (((ob >> 9) & 1) << 5)); }
__host__ __device__ __forceinline__ void stage_rc(int b, int& R, int& C) { const int st = b / 1024, sb = b % 1024, swz = sb ^ (((sb >> 9) & 1) << 5); R = (st >> 1) * 16 + swz / 64; C = (st & 1) * 32 + (swz % 64) / 2; }
__host__ __device__ __forceinline__ int perm32(int rho) { const int n = rho >> 4, i = rho & 15; return 8 * (i >> 2) + 4 * n + (i & 3); }

struct Unit { int pm, pn, brow; };
struct Gemm { const bf16_t* A; const bf16_t* Bt; int lda, ldb, K; };

struct StaticOrder {
    int nM, nN, nwg, G, c;
    __device__ void init(int M, int N, int G_, int c_) { nM = M / BM; nN = N / BM; nwg = nM * nN; G = G_; c = c_; }
    __device__ bool next(int i, Unit& u) const {
        const long L = (long)i * G + c; if (L >= nwg) return false;
        int wgid = (int)L; { const int q = nwg / NXCD, r = nwg % NXCD, xcd = wgid % NXCD, off = wgid / NXCD; wgid = (xcd < r ? xcd * (q + 1) : r * (q + 1) + (xcd - r) * q) + off; }
        const int nig = WGM * nN, gid = wgid / nig, fm = gid * WGM, gsz = (nM - fm) < WGM ? (nM - fm) : WGM;
        u.pm = fm + ((wgid % nig) % gsz); u.pn = (wgid % nig) / gsz; u.brow = u.pn * BM; return true;
    }
};
struct MoeOrder {
    const int* tiles; int G, c, rows_per_expert;
    __device__ bool next(int i, Unit& u) const {
        const int nt = tiles[0]; const int L = i * G + c; if (L >= nt * 4) return false;
        const int t = L >> 2; u.pm = t; u.pn = L & 3; u.brow = tiles[1 + t] * rows_per_expert + u.pn * BM; return true;
    }
};

struct EpiF32 {
    static constexpr bool PERM = false;
    float* C; int ldc;
    __device__ __forceinline__ void operator()(const f32x4 (&acc)[2][2][4][2], const Unit& u, int wr, int wc, int fr, int fq) const {
        const int row0 = u.pm * BM + wr * 64 + fr, col0 = u.pn * BM + wc * 32 + 4 * fq;
#pragma unroll
        for (int ai = 0; ai < 2; ++ai)
#pragma unroll
            for (int m = 0; m < 4; ++m) { float* rowp = C + (size_t)(row0 + ai * HALF + m * 16) * ldc + col0;
#pragma unroll
                for (int bj = 0; bj < 2; ++bj)
#pragma unroll
                    for (int n = 0; n < 2; ++n) *(f32x4*)(rowp + bj * HALF + n * 16) = acc[ai][bj][m][n]; }
    }
};
struct EpiBf16 {
    static constexpr bool PERM = true;
    bf16_t* O; int ldc; int split_cols; size_t split_stride;
    __device__ __forceinline__ void operator()(const f32x4 (&acc)[2][2][4][2], const Unit& u, int wr, int wc, int fr, int fq) const {
        const int row0 = u.pm * BM + wr * 64 + fr; int colt = u.pn * BM; bf16_t* base = O;
        if (split_cols) { const int t = colt / split_cols; base += (size_t)t * split_stride; colt -= t * split_cols; }
        const int col0 = colt + wc * 32 + 8 * fq;
#pragma unroll
        for (int ai = 0; ai < 2; ++ai)
#pragma unroll
            for (int m = 0; m < 4; ++m) { bf16_t* rowp = base + (size_t)(row0 + ai * HALF + m * 16) * ldc + col0;
#pragma unroll
                for (int bj = 0; bj < 2; ++bj) { const f32x4 v0 = acc[ai][bj][m][0], v1 = acc[ai][bj][m][1];
                    u32x4 w; w.x = cvtpk(v0[0], v0[1]); w.y = cvtpk(v0[2], v0[3]); w.z = cvtpk(v1[0], v1[1]); w.w = cvtpk(v1[2], v1[3]);
                    *(u32x4*)(rowp + bj * HALF) = w; } }
    }
};
struct EpiGU {
    static constexpr bool PERM = true;
    bf16_t* H; int ldh;
    __device__ __forceinline__ void operator()(const f32x4 (&acc)[2][2][4][2], const Unit& u, int wr, int wc, int fr, int fq) const {
        const int row0 = u.pm * BM + wr * 64 + fr, col0 = u.pn * HALF + wc * 32 + 8 * fq;
#pragma unroll
        for (int ai = 0; ai < 2; ++ai)
#pragma unroll
            for (int m = 0; m < 4; ++m) { bf16_t* rowp = H + (size_t)(row0 + ai * HALF + m * 16) * ldh + col0;
                float h[8];
#pragma unroll
                for (int n = 0; n < 2; ++n)
#pragma unroll
                    for (int j = 0; j < 4; ++j) h[n * 4 + j] = silu_f(acc[ai][0][m][n][j]) * acc[ai][1][m][n][j];
                u32x4 w; w.x = cvtpk(h[0], h[1]); w.y = cvtpk(h[2], h[3]); w.z = cvtpk(h[4], h[5]); w.w = cvtpk(h[6], h[7]);
                *(u32x4*)rowp = w; }
    }
};
struct EpiDown {
    static constexpr bool PERM = true; static constexpr bool ROWINFO_LDS = true;
    bf16_t* YS; const int2* rowinfo;
    __device__ __forceinline__ void operator()(const f32x4 (&acc)[2][2][4][2], const Unit& u, int wr, int wc, int fr, int fq, const LAS i32x2* ril) const {
        const int lrow0 = wr * 64 + fr, col0 = u.pn * BM + wc * 32 + 8 * fq;
#pragma unroll
        for (int ai = 0; ai < 2; ++ai)
#pragma unroll
            for (int m = 0; m < 4; ++m) { const i32x2 ri = ril[lrow0 + ai * HALF + m * 16];
                if (ri.x >= 0) { const float g = __int_as_float(ri.y); const int tok = ri.x >> 1, k = ri.x & 1;
                    bf16_t* rowp = YS + ((size_t)k * NTOK + tok) * DM + col0;
#pragma unroll
                    for (int bj = 0; bj < 2; ++bj) { const f32x4 v0 = acc[ai][bj][m][0] * g, v1 = acc[ai][bj][m][1] * g;
                        u32x4 w; w.x = cvtpk(v0[0], v0[1]); w.y = cvtpk(v0[2], v0[3]); w.z = cvtpk(v1[0], v1[1]); w.w = cvtpk(v1[2], v1[3]);
                        *(u32x4*)(rowp + bj * HALF) = w; } } }
    }
};

template <int NRMS, bool ROPE, bool KSKIP> struct EpiNormUp {
    static constexpr bool PERM = true;
    bf16_t* O; int ldc; int split_cols; size_t split_stride; const bf16_t* Zs; int ldz; const float* cosT; const float* sinT;
    __device__ __forceinline__ void operator()(const f32x4 (&acc)[2][2][4][2], const Unit& u, int wr, int wc, int fr_, int fq_) const {
        int fr = fr_, fq = fq_; asm volatile("" : "+v"(fr), "+v"(fq));
        const int row0 = u.pm * BM + wr * 64 + fr; int colt = u.pn * BM; bf16_t* base = O; bool kpart = false;
        if (split_cols) { const int t = colt / split_cols; base += (size_t)t * split_stride; colt -= t * split_cols; kpart = (t == 0); }
        if (KSKIP && kpart && wc >= 2) return;
        const int col0 = colt + wc * 32 + 8 * fq;
        constexpr int NL = NRMS > 0 ? NRMS / 32 : 1;
#pragma unroll
        for (int ai = 0; ai < 2; ++ai) {
            float rstd[4] = {1.f, 1.f, 1.f, 1.f};
            constexpr int RB = (NRMS > 128) ? 1 : 2;
            if constexpr (NRMS > 0) {
#pragma unroll
            for (int mp = 0; mp < 4; mp += RB) {
                u32x4 zw[RB][NL];
#pragma unroll
                for (int m2 = 0; m2 < RB; ++m2)
#pragma unroll
                    for (int q = 0; q < NL; ++q) zw[m2][q] = *(const u32x4*)(Zs + (size_t)(row0 + ai * HALF + (mp + m2) * 16) * ldz + fq * (NRMS / 4) + q * 8);
#pragma unroll
                for (int m2 = 0; m2 < RB; ++m2) { float ss = 0.f;
#pragma unroll
                    for (int q = 0; q < NL; ++q) { const u32x4 w = zw[m2][q]; const float a0 = bflo(w.x), a1 = bfhi(w.x), a2 = bflo(w.y), a3 = bfhi(w.y), a4 = bflo(w.z), a5 = bfhi(w.z), a6 = bflo(w.w), a7 = bfhi(w.w);
                        ss += (a0 * a0 + a1 * a1) + (a2 * a2 + a3 * a3) + (a4 * a4 + a5 * a5) + (a6 * a6 + a7 * a7); }
                    ss += __shfl_xor(ss, 16); ss += __shfl_xor(ss, 32);
                    rstd[mp + m2] = 1.f / sqrtf(ss * (1.f / (NRMS > 0 ? NRMS : 1)) + 1e-6f); }
                __builtin_amdgcn_sched_barrier(0);
            } }
#pragma unroll
            for (int m = 0; m < 4; ++m) { const int row = row0 + ai * HALF + m * 16; bf16_t* rowp = base + (size_t)row * ldc + col0;
                f32x4 cs = {1.f, 1.f, 1.f, 1.f}, sn = {0.f, 0.f, 0.f, 0.f};
                if (ROPE && wc == 2) { const int pos = row & (SEQ - 1); cs = *(const f32x4*)(cosT + (size_t)pos * 16 + 4 * fq); sn = *(const f32x4*)(sinT + (size_t)pos * 16 + 4 * fq); }
#pragma unroll
                for (int bj = 0; bj < 2; ++bj) { f32x4 v0 = acc[ai][bj][m][0] * rstd[m], v1 = acc[ai][bj][m][1] * rstd[m];
                    if (ROPE && wc == 2) {
                        const f32x4 a = v0, b = v1;
                        v0[0] = a[0] * cs[0] - a[1] * sn[0]; v0[1] = a[1] * cs[0] + a[0] * sn[0]; v0[2] = a[2] * cs[1] - a[3] * sn[1]; v0[3] = a[3] * cs[1] + a[2] * sn[1];
                        v1[0] = b[0] * cs[2] - b[1] * sn[2]; v1[1] = b[1] * cs[2] + b[0] * sn[2]; v1[2] = b[2] * cs[3] - b[3] * sn[3]; v1[3] = b[3] * cs[3] + b[2] * sn[3]; }
                    u32x4 w; w.x = cvtpk(v0[0], v0[1]); w.y = cvtpk(v0[2], v0[3]); w.z = cvtpk(v1[0], v1[1]); w.w = cvtpk(v1[2], v1[3]);
                    *(u32x4*)(rowp + bj * HALF) = w; } }
        }
    }
};

template <class T, class = void> struct epi_rowinfo_lds { static constexpr bool value = false; };
template <class T> struct epi_rowinfo_lds<T, decltype((void)T::ROWINFO_LDS)> { static constexpr bool value = T::ROWINFO_LDS; };
template <class Epi, class Sched, bool ALIGN_EPI, bool GATHER = false>
__device__ __forceinline__ void gemm_phase(LAS unsigned char* lds, const Gemm g, const Sched& S, const Epi& E, int WV_, const int2* rowinfo = nullptr) {
    const int tid = otid(), wid = __builtin_amdgcn_readfirstlane(tid >> 6), lane = tid & 63, wr = wid >> 2, wc = wid & 3, fr = lane & 15, fq = lane >> 4;
    const int K = g.K, nt = K / BK;
    unsigned voffA[2], voffB[2], voffA1[2] = {0u, 0u}, nvoffA[2] = {0u, 0u}, nvoffA1[2] = {0u, 0u};
    int stR[2], stC[2];
#pragma unroll
    for (int i = 0; i < 2; ++i) { int R, C; stage_rc(tid * 16 + i * 8192, R, C); const int Rb = Epi::PERM ? ((R & ~31) + perm32(R & 31)) : R; stR[i] = R; stC[i] = C;
        voffA[i] = (unsigned)(R * g.lda + C) * 2u; voffB[i] = (unsigned)(Rb * g.ldb + C) * 2u; }
#define PG8_GOFF(o0, o1, pm_) do { _Pragma("unroll") for (int _i = 0; _i < 2; ++_i) { const int r0_ = (pm_) * BM + stR[_i]; const int t0_ = rowinfo[r0_].x, t1_ = rowinfo[r0_ + HALF].x; \
        (o0)[_i] = (unsigned)(((t0_ < 0 ? 0 : t0_) >> 1) * g.lda + stC[_i]) * 2u; (o1)[_i] = (unsigned)(((t1_ < 0 ? 0 : t1_) >> 1) * g.lda + stC[_i]) * 2u; } } while (0)
#define PG8_STAGE_A(bufoff, a, h, o0, o1) do { if constexpr (GATHER) { if (h) PG8_STAGE(bufoff, a, o1); else PG8_STAGE(bufoff, a, o0); } else PG8_STAGE(bufoff, (a) + (h) * hstepA, voffA); } while (0)
    const size_t kstep = (size_t)(BK * 2);
    const size_t hstepA = (size_t)HALF * g.lda * 2, hstepB = (size_t)HALF * g.ldb * 2;
    const unsigned ldsw = (unsigned)wid * 1024u;
    const int aoff = lds_byte(wr * 64 + fr, fq * 8), boff = lds_byte(wc * 32 + fr, fq * 8);
#define PG8_SA(b, h) (((b) * 2 + (h)) * HTB)
#define PG8_SB(b, h) ((4 + (b) * 2 + (h)) * HTB)
#define PG8_STAGE(bufoff, gbase, voff) do { _Pragma("unroll") for (int _i = 0; _i < 2; ++_i) \
        __builtin_amdgcn_global_load_lds((const unsigned*)((const char*)(gbase) + (voff)[_i]), (LAS unsigned*)(lds + (bufoff) + ldsw + _i * 8192), 16, 0, 0); } while (0)
#define PG8_LDA(dst, b, h) do { _Pragma("unroll") for (int m = 0; m < 4; ++m) _Pragma("unroll") for (int k = 0; k < 2; ++k) dst[m][k] = *(const LAS bf16x8*)(lds + PG8_SA(b, h) + aoff + m * 2048 + k * 1024); } while (0)
#define PG8_LDB(dst, b, h) do { _Pragma("unroll") for (int n = 0; n < 2; ++n) _Pragma("unroll") for (int k = 0; k < 2; ++k) dst[n][k] = *(const LAS bf16x8*)(lds + PG8_SB(b, h) + boff + n * 2048 + k * 1024); } while (0)
#define PG8_MMA(ai, bj, At, Bt) do { __builtin_amdgcn_s_setprio(1); _Pragma("unroll") for (int m = 0; m < 4; ++m) _Pragma("unroll") for (int n = 0; n < 2; ++n) _Pragma("unroll") for (int k = 0; k < 2; ++k) \
        acc[ai][bj][m][n] = __builtin_amdgcn_mfma_f32_16x16x32_bf16(Bt[n][k], At[m][k], acc[ai][bj][m][n], 0, 0, 0); __builtin_amdgcn_s_setprio(0); } while (0)
#define PG8_WAIT_V(n) asm volatile("s_waitcnt vmcnt(" #n ")" ::: "memory")
#define PG8_WAIT_L(n) asm volatile("s_waitcnt lgkmcnt(" #n ")" ::: "memory")
#define PG8_BAR __builtin_amdgcn_s_barrier()
#define PG8_SCHED __builtin_amdgcn_sched_barrier(0)
    Unit cur, nxt; int ui = 0;
    if (!S.next(0, cur)) return;
    f32x4 acc[2][2][4][2];
#pragma unroll
    for (int a = 0; a < 2; ++a)
#pragma unroll
        for (int b = 0; b < 2; ++b)
#pragma unroll
            for (int m = 0; m < 4; ++m)
#pragma unroll
                for (int n = 0; n < 2; ++n) acc[a][b][m][n] = (f32x4){0.f, 0.f, 0.f, 0.f};
    bf16x8 At[4][2], B0[2][2], B1[2][2];
    const char* cA = (const char*)g.A + (GATHER ? (size_t)0 : (size_t)cur.pm * 2 * hstepA); const char* cB = (const char*)g.Bt + (size_t)cur.brow * g.ldb * 2;
    if constexpr (GATHER) { PG8_GOFF(voffA, voffA1, cur.pm); }
    PG8_STAGE(PG8_SB(0, 0), cB, voffB); PG8_STAGE(PG8_SB(0, 1), cB + hstepB, voffB); PG8_STAGE_A(PG8_SA(0, 0), cA, 0, voffA, voffA1); PG8_STAGE_A(PG8_SA(0, 1), cA, 1, voffA, voffA1);
    if (wr == 1) PG8_BAR;
    PG8_WAIT_V(2); PG8_BAR;
    PG8_STAGE(PG8_SB(1, 0), cB + kstep, voffB); PG8_STAGE_A(PG8_SA(1, 0), cA + kstep, 0, voffA, voffA1); PG8_STAGE(PG8_SB(1, 1), cB + hstepB + kstep, voffB);
    PG8_WAIT_V(6); PG8_BAR;
    for (;;) {
        if constexpr (epi_rowinfo_lds<Epi>::value) {
            if (tid < 256) { const int2 rv = E.rowinfo[cur.pm * BM + tid]; ((LAS i32x2*)(lds + 132096 + (ui & 1) * 2048))[tid] = (i32x2){rv.x, rv.y}; } }
        const bool has_next = S.next(ui + 1, nxt);
        const char* nA = has_next ? (const char*)g.A + (GATHER ? (size_t)0 : (size_t)nxt.pm * 2 * hstepA) : cA; const char* nB = has_next ? (const char*)g.Bt + (size_t)nxt.brow * g.ldb * 2 : cB;
        if constexpr (GATHER) {
            if (has_next) { PG8_GOFF(nvoffA, nvoffA1, nxt.pm); } else { nvoffA[0] = voffA[0]; nvoffA[1] = voffA[1]; nvoffA1[0] = voffA1[0]; nvoffA1[1] = voffA1[1]; }
            asm volatile("s_waitcnt vmcnt(0)" : "+v"(nvoffA[0]), "+v"(nvoffA[1]), "+v"(nvoffA1[0]), "+v"(nvoffA1[1]) :: "memory"); }
        for (int t = 0; t < nt; t += 2) {
            const bool last = (t == nt - 2);
            const char* a1 = cA + (size_t)(t + 1) * kstep;
            const char* a2 = last ? nA : cA + (size_t)(t + 2) * kstep; const char* b2 = last ? nB : cB + (size_t)(t + 2) * kstep;
            const char* a3 = a2 + kstep; const char* b3 = b2 + kstep;
            unsigned xo0[2], xo1[2];
#pragma unroll
            for (int _i = 0; _i < 2; ++_i) { xo0[_i] = last ? nvoffA[_i] : voffA[_i]; xo1[_i] = last ? nvoffA1[_i] : voffA1[_i]; }
            PG8_LDB(B0, 0, 0); PG8_LDB(B1, 0, 1); PG8_SCHED; PG8_LDA(At, 0, 0); PG8_STAGE_A(PG8_SA(1, 1), a1, 1, voffA, voffA1);
            PG8_WAIT_V(8); PG8_WAIT_L(0); PG8_BAR; PG8_MMA(0, 0, At, B0); PG8_MMA(0, 1, At, B1); PG8_BAR; PG8_SCHED;
            PG8_LDA(At, 0, 1); PG8_STAGE(PG8_SB(0, 0), b2, voffB); PG8_STAGE(PG8_SB(0, 1), b2 + hstepB, voffB); PG8_STAGE_A(PG8_SA(0, 0), a2, 0, xo0, xo1);
            PG8_WAIT_V(8); PG8_WAIT_L(0); PG8_BAR; PG8_MMA(1, 0, At, B0); PG8_MMA(1, 1, At, B1); PG8_BAR; PG8_SCHED;
            PG8_LDB(B0, 1, 0); PG8_LDB(B1, 1, 1); PG8_SCHED; PG8_LDA(At, 1, 0); PG8_STAGE_A(PG8_SA(0, 1), a2, 1, xo0, xo1);
            PG8_WAIT_V(8); PG8_WAIT_L(0); PG8_BAR; PG8_MMA(0, 0, At, B0); PG8_MMA(0, 1, At, B1); PG8_BAR; PG8_SCHED;
            PG8_LDA(At, 1, 1); PG8_STAGE(PG8_SB(1, 0), b3, voffB); PG8_STAGE(PG8_SB(1, 1), b3 + hstepB, voffB); PG8_STAGE_A(PG8_SA(1, 0), a3, 0, xo0, xo1);
            PG8_WAIT_V(8); PG8_WAIT_L(0); PG8_BAR; PG8_MMA(1, 0, At, B0); PG8_MMA(1, 1, At, B1); PG8_BAR; PG8_SCHED;
        }
        if constexpr (ALIGN_EPI) { if (wr == 0) PG8_BAR; }
        if constexpr (epi_rowinfo_lds<Epi>::value) E(acc, cur, wr, wc, fr, fq, (const LAS i32x2*)(lds + 132096 + (ui & 1) * 2048));
        else E(acc, cur, wr, wc, fr, fq);
        if (!has_next) break;
#pragma unroll
        for (int a = 0; a < 2; ++a)
#pragma unroll
            for (int b = 0; b < 2; ++b)
#pragma unroll
                for (int m = 0; m < 4; ++m)
#pragma unroll
                    for (int n = 0; n < 2; ++n) acc[a][b][m][n] = (f32x4){0.f, 0.f, 0.f, 0.f};
        cur = nxt; cA = nA; cB = nB; ++ui;
        if constexpr (GATHER) { voffA[0] = nvoffA[0]; voffA[1] = nvoffA[1]; voffA1[0] = nvoffA1[0]; voffA1[1] = nvoffA1[1]; }
        if constexpr (ALIGN_EPI) { if (wr == 1) PG8_BAR; }
    }
    PG8_WAIT_V(0);
    if constexpr (!ALIGN_EPI) { if (wr == 0) PG8_BAR; }
    PG8_BAR;
#undef PG8_SA
#undef PG8_SB
#undef PG8_STAGE
#undef PG8_STAGE_A
#undef PG8_GOFF
#undef PG8_LDA
#undef PG8_LDB
#undef PG8_MMA
#undef PG8_WAIT_V
#undef PG8_WAIT_L
#undef PG8_BAR
#undef PG8_SCHED
}
}

namespace att {
constexpr int NW = 8, QBLK = 32, KVBLK = 64;
constexpr float THR = 8.f;
constexpr size_t SHM_V = KVBLK * 128 * 2, SHM_K = KVBLK * 128 * 2, SHM_ATTN = 2 * SHM_V + 2 * SHM_K + NW * 64 * 4;
#define KSWZ(row, colB) ((row) * 256 + ((colB) ^ (((row) & 7) << 4)))
#define KSWZ64(row, colB) ((row) * 128 + ((colB) ^ (((row) & 7) << 4)))
#define SBAR() __builtin_amdgcn_sched_barrier(0)
__device__ __forceinline__ int crow(int r, int hi) { return (r & 3) + 8 * (r >> 2) + 4 * hi; }
__device__ __forceinline__ bf16x8 ld8(const bf16_t* p) { return *reinterpret_cast<const bf16x8*>(p); }

__device__ __forceinline__ void partialSM(f32x16& p0, f32x16& p1, float& m_reg, float& mn, float& alpha, float C, float thr_raw) {
  float pmax = p0[0];
#pragma unroll
  for (int r = 1; r < 16; ++r) pmax = fmaxf(pmax, p0[r]);
#pragma unroll
  for (int r = 0; r < 16; ++r) pmax = fmaxf(pmax, p1[r]);
  { auto rr = __builtin_amdgcn_permlane32_swap(__float_as_uint(pmax), __float_as_uint(pmax), false, false);
    pmax = fmaxf(__uint_as_float(rr[0]), __uint_as_float(rr[1])); }
  if (__builtin_expect(__all(pmax - m_reg <= thr_raw), 1)) { mn = m_reg; alpha = 1.f; }
  else { mn = fmaxf(m_reg, pmax); alpha = __builtin_amdgcn_exp2f((m_reg - mn) * C); m_reg = mn; }
  float mnC = -mn * C;
#pragma unroll
  for (int r = 0; r < 16; ++r) p0[r] = fmaf(p0[r], C, mnC);
#pragma unroll
  for (int r = 0; r < 16; ++r) p1[r] = fmaf(p1[r], C, mnC);
#pragma unroll
  for (int r = 0; r < 16; ++r) p0[r] = __builtin_amdgcn_exp2f(p0[r]);
}
#define PK4(P, BASE, OUT) do { u32x4 w = {cvtpk(P[BASE + 0], P[BASE + 1]), cvtpk(P[BASE + 2], P[BASE + 3]), cvtpk(P[BASE + 4], P[BASE + 5]), cvtpk(P[BASE + 6], P[BASE + 7])}; \
    OUT = *reinterpret_cast<bf16x8*>(&w); } while (0)
__device__ __forceinline__ void finishSM(f32x16& p0, f32x16& p1, bf16x8& pa0, bf16x8& pa1, bf16x8& pa2, bf16x8& pa3) {
#pragma unroll
  for (int r = 0; r < 16; ++r) p1[r] = __builtin_amdgcn_exp2f(p1[r]);
  PK4(p0, 0, pa0); PK4(p0, 8, pa1); PK4(p1, 0, pa2); PK4(p1, 8, pa3);
}
template <int D0_LO, int D0_HI>
__device__ __forceinline__ void qkt(f32x16& p0, f32x16& p1, const bf16_t* Ks, const bf16x8* qr, int r32, int hi) {
  p0 = f32x16{}; p1 = f32x16{};
#pragma unroll
  for (int d0 = D0_LO; d0 < D0_HI; ++d0) { int cb = (d0 * 16 + hi * 8) * 2;
    bf16x8 b0 = *reinterpret_cast<const bf16x8*>((const char*)Ks + KSWZ(r32, cb));
    bf16x8 b1 = *reinterpret_cast<const bf16x8*>((const char*)Ks + KSWZ(32 + r32, cb));
    p0 = __builtin_amdgcn_mfma_f32_32x32x16_bf16(b0, qr[d0], p0, 0, 0, 0);
    p1 = __builtin_amdgcn_mfma_f32_32x32x16_bf16(b1, qr[d0], p1, 0, 0, 0); }
}
__device__ __forceinline__ void qkt64(f32x16& p0, f32x16& p1, const bf16_t* Ks, const bf16x8* qr, int r32, int hi) {
  p0 = f32x16{}; p1 = f32x16{};
#pragma unroll
  for (int d0 = 0; d0 < 4; ++d0) { int cb = (d0 * 16 + hi * 8) * 2;
    bf16x8 b0 = *reinterpret_cast<const bf16x8*>((const char*)Ks + KSWZ64(r32, cb));
    bf16x8 b1 = *reinterpret_cast<const bf16x8*>((const char*)Ks + KSWZ64(32 + r32, cb));
    p0 = __builtin_amdgcn_mfma_f32_32x32x16_bf16(b0, qr[d0], p0, 0, 0, 0);
    p1 = __builtin_amdgcn_mfma_f32_32x32x16_bf16(b1, qr[d0], p1, 0, 0, 0); }
}
__device__ __forceinline__ int v_st(int k, int c) { const int kk = k; return ((kk >> 3) * 4 + (c >> 5)) * 512 + ((kk & 7) * 32 + (c & 31)) * 2; }
__device__ __forceinline__ int v_rd_base(int lane) { return ((lane & 3) << 3) | (((lane >> 2) & 3) << 6) | (((lane >> 4) & 1) << 5) | (((lane >> 5) & 1) << 8); }
__host__ __device__ constexpr int v_rd_off(int d0, int ks, int half) { return d0 * 512 + ks * 4096 + half * 2048; }
template <int OFF> __device__ __forceinline__ s16x4 tr_read(int vb) {
  s16x4 r; asm volatile("ds_read_b64_tr_b16 %0, %1 offset:%2" : "=&v"(r) : "v"(vb), "i"(OFF) : "memory"); return r;
}
template <int D0> __device__ __forceinline__ void pv_one(f32x16& od, int vb, bf16x8 pa0, bf16x8 pa1, bf16x8 pa2, bf16x8 pa3) {
  const s16x4 l0 = tr_read<v_rd_off(D0, 0, 0)>(vb), h0 = tr_read<v_rd_off(D0, 0, 1)>(vb), l1 = tr_read<v_rd_off(D0, 1, 0)>(vb), h1 = tr_read<v_rd_off(D0, 1, 1)>(vb);
  const s16x4 l2 = tr_read<v_rd_off(D0, 2, 0)>(vb), h2 = tr_read<v_rd_off(D0, 2, 1)>(vb), l3 = tr_read<v_rd_off(D0, 3, 0)>(vb), h3 = tr_read<v_rd_off(D0, 3, 1)>(vb);
  asm volatile("s_waitcnt lgkmcnt(0)" ::: "memory"); SBAR();
#define PKV(L, H) (bf16x8){L[0], L[1], L[2], L[3], H[0], H[1], H[2], H[3]}
  od = __builtin_amdgcn_mfma_f32_32x32x16_bf16(pa0, PKV(l0, h0), od, 0, 0, 0);
  od = __builtin_amdgcn_mfma_f32_32x32x16_bf16(pa1, PKV(l1, h1), od, 0, 0, 0);
  od = __builtin_amdgcn_mfma_f32_32x32x16_bf16(pa2, PKV(l2, h2), od, 0, 0, 0);
  od = __builtin_amdgcn_mfma_f32_32x32x16_bf16(pa3, PKV(l3, h3), od, 0, 0, 0);
}
__device__ __forceinline__ void pv_l(f32x16* o, f32x16& l, int vb, bf16x8 pa0, bf16x8 pa1, bf16x8 pa2, bf16x8 pa3) {
  const bf16x8 ones = {0x3F80, 0x3F80, 0x3F80, 0x3F80, 0x3F80, 0x3F80, 0x3F80, 0x3F80};
  pv_one<0>(o[0], vb, pa0, pa1, pa2, pa3); l = __builtin_amdgcn_mfma_f32_32x32x16_bf16(pa0, ones, l, 0, 0, 0);
  pv_one<1>(o[1], vb, pa0, pa1, pa2, pa3); l = __builtin_amdgcn_mfma_f32_32x32x16_bf16(pa1, ones, l, 0, 0, 0);
  pv_one<2>(o[2], vb, pa0, pa1, pa2, pa3); l = __builtin_amdgcn_mfma_f32_32x32x16_bf16(pa2, ones, l, 0, 0, 0);
  pv_one<3>(o[3], vb, pa0, pa1, pa2, pa3); l = __builtin_amdgcn_mfma_f32_32x32x16_bf16(pa3, ones, l, 0, 0, 0);
}
__device__ __forceinline__ void pv_d0(f32x16* o, int vb, bf16x8 pa0, bf16x8 pa1, bf16x8 pa2, bf16x8 pa3) {
  pv_one<0>(o[0], vb, pa0, pa1, pa2, pa3); pv_one<1>(o[1], vb, pa0, pa1, pa2, pa3); pv_one<2>(o[2], vb, pa0, pa1, pa2, pa3); pv_one<3>(o[3], vb, pa0, pa1, pa2, pa3);
}

template <int D0_LO, int D0_HI, typename TO, bool DIFF = false>
__device__ __forceinline__ void attn_dense_body(const bf16_t* __restrict__ Qb, int ldq, const bf16_t* __restrict__ Kh, int ldk, const bf16_t* __restrict__ Vh, int ldv,
                                                TO* __restrict__ Ob, int ldo, int seq, float scale, char* lds,
                                                int WV_, const float* OA = nullptr, int ldoa = 0, float lam = 0.f, const float* subln = nullptr, const bf16_t* QN = nullptr, int ldqn = 0) {
  const int tid = otid(), wid = tid >> 6, lane = tid & 63, r32 = lane & 31, hi = lane >> 5;
  float C = scale * 1.4426950408889634f, thr_raw = THR / scale;
  if (QN) {
    const bf16_t* qn = QN + (long)(wid * QBLK + r32) * ldqn + hi * 128; float ss = 0.f;
#pragma unroll
    for (int q = 0; q < 16; ++q) { const u32x4 w = *(const u32x4*)(qn + q * 8); const float a0 = bflo(w.x), a1 = bfhi(w.x), a2 = bflo(w.y), a3 = bfhi(w.y), a4 = bflo(w.z), a5 = bfhi(w.z), a6 = bflo(w.w), a7 = bfhi(w.w);
      ss += (a0 * a0 + a1 * a1) + (a2 * a2 + a3 * a3) + (a4 * a4 + a5 * a5) + (a6 * a6 + a7 * a7); }
    ss += __shfl_xor(ss, 32);
    const float rq = 1.f / sqrtf(ss * (1.f / 256.f) + 1e-6f); C *= rq; thr_raw /= rq; }
  bf16_t* V_lds = (bf16_t*)lds; bf16_t* K_lds = (bf16_t*)(lds + 2 * SHM_V);
  float* ws = (float*)(lds + 2 * SHM_V + 2 * SHM_K) + wid * 64; float* al_l = ws + 32;
  float m_reg = -1e30f; f32x16 o[4] = {}; f32x16 lacc = {}; bf16x8 qr[8];
  const bf16_t* Qw = Qb + (long)(wid * QBLK + r32) * ldq + hi * 8;
#pragma unroll
  for (int d0 = 0; d0 < 8; ++d0) qr[d0] = (d0 >= D0_LO && d0 < D0_HI) ? ld8(Qw + d0 * 16) : bf16x8{};
  const int sr = tid >> 4, sc = (tid & 15) * 8, vst0 = v_st(sr, sc), vst1 = v_st(32 + sr, sc);
  const int vb0 = (int)(uintptr_t)V_lds + v_rd_base(lane);
  struct { bf16x8 vs0, vs1, ks0, ks1; } sr_[2];
#define SLOAD(i, k0) do { sr_[i].vs0 = ld8(&Vh[(long)((k0) + sr) * ldv + sc]); sr_[i].vs1 = ld8(&Vh[(long)((k0) + 32 + sr) * ldv + sc]); \
    sr_[i].ks0 = ld8(&Kh[(long)((k0) + sr) * ldk + sc]); sr_[i].ks1 = ld8(&Kh[(long)((k0) + 32 + sr) * ldk + sc]); } while (0)
#define SWRITE(b, i) do { *(bf16x8*)((char*)V_lds + (b) * SHM_V + vst0) = sr_[i].vs0;          \
    *(bf16x8*)((char*)V_lds + (b) * SHM_V + vst1) = sr_[i].vs1; int kc = sc * 2;               \
    *(bf16x8*)((char*)K_lds + (b) * SHM_K + KSWZ(sr, kc)) = sr_[i].ks0;                       \
    *(bf16x8*)((char*)K_lds + (b) * SHM_K + KSWZ(32 + sr, kc)) = sr_[i].ks1; } while (0)
#define SWAIT() asm volatile("s_waitcnt vmcnt(4)" ::: "memory")
#define RESC(a) do { if (__any((a) < 1.f)) { if (hi == 0) al_l[r32] = (a); asm volatile("s_waitcnt lgkmcnt(0)" ::: "memory"); \
    _Pragma("unroll") for (int r = 0; r < 16; ++r) { const float av = al_l[crow(r, hi)]; lacc[r] *= av; _Pragma("unroll") for (int d = 0; d < 4; ++d) o[d][r] *= av; } } } while (0)
  f32x16 pA0, pA1, pB0, pB1; float mnA, mnB, alA, alB; bf16x8 pa0, pa1, pa2, pa3; const int NT = seq / KVBLK;
  constexpr int SE = 0, SO = 1;
  SLOAD(SE, 0); asm volatile("s_waitcnt vmcnt(0)" ::: "memory"); SWRITE(0, SE); __syncthreads();
  qkt<D0_LO, D0_HI>(pA0, pA1, K_lds, qr, r32, hi); partialSM(pA0, pA1, m_reg, mnA, alA, C, thr_raw);
  SLOAD(SO, KVBLK); if (2 < NT) SLOAD(SE, 2 * KVBLK);
  SWAIT(); SWRITE(1, SO); __syncthreads();
  for (int j = 1; j + 1 < NT; j += 2) {
    SBAR(); qkt<D0_LO, D0_HI>(pB0, pB1, (bf16_t*)((char*)K_lds + SHM_K), qr, r32, hi);
    finishSM(pA0, pA1, pa0, pa1, pa2, pa3); SBAR();
    SLOAD(SO, (j + 2) * KVBLK); SBAR();
    pv_l(o, lacc, vb0, pa0, pa1, pa2, pa3); partialSM(pB0, pB1, m_reg, mnB, alB, C, thr_raw);
    __syncthreads(); SWAIT(); SWRITE(0, SE);
    RESC(alB); __syncthreads();
    SBAR(); qkt<D0_LO, D0_HI>(pA0, pA1, K_lds, qr, r32, hi);
    finishSM(pB0, pB1, pa0, pa1, pa2, pa3); SBAR();
    if (j + 3 < NT) SLOAD(SE, (j + 3) * KVBLK); SBAR();
    pv_l(o, lacc, vb0 + (int)SHM_V, pa0, pa1, pa2, pa3); partialSM(pA0, pA1, m_reg, mnA, alA, C, thr_raw);
    __syncthreads(); SWAIT(); SWRITE(1, SO);
    RESC(alA); __syncthreads();
  }
  SBAR(); qkt<D0_LO, D0_HI>(pB0, pB1, (bf16_t*)((char*)K_lds + SHM_K), qr, r32, hi);
  finishSM(pA0, pA1, pa0, pa1, pa2, pa3); SBAR();
  pv_l(o, lacc, vb0, pa0, pa1, pa2, pa3); partialSM(pB0, pB1, m_reg, mnB, alB, C, thr_raw);
  __syncthreads(); RESC(alB);
  finishSM(pB0, pB1, pa0, pa1, pa2, pa3); SBAR();
  pv_l(o, lacc, vb0 + (int)SHM_V, pa0, pa1, pa2, pa3);
  float rli[16];
#pragma unroll
  for (int r = 0; r < 16; ++r) rli[r] = __builtin_amdgcn_rcpf(lacc[r]);
  TO* Ow = Ob + (long)(wid * QBLK) * ldo;
  if constexpr (DIFF) {
    const float* OA2 = OA; asm volatile("" : "+s"(OA2));
    const float* OAw = OA2 + (long)(wid * QBLK) * ldoa;
    float sg[4];
#pragma unroll
    for (int d0 = 0; d0 < 4; ++d0) sg[d0] = subln[d0 * 32 + r32] * 0.8f;
#pragma unroll
    for (int r = 0; r < 16; ++r) { int orow = crow(r, hi); float ov[4]; float ss = 0.f;
#pragma unroll
      for (int d0 = 0; d0 < 4; ++d0) { const float va = OAw[(long)orow * ldoa + d0 * 32 + r32]; ov[d0] = va - lam * (o[d0][r] * rli[r]); ss += ov[d0] * ov[d0]; }
      ss = half_sum(ss); const float rs = 1.f / sqrtf(ss * (1.f / 128.f) + 1e-6f);
#pragma unroll
      for (int d0 = 0; d0 < 4; ++d0) Ow[(long)orow * ldo + d0 * 32 + r32] = (TO)f2bf(ov[d0] * rs * sg[d0]); }
  } else {
#pragma unroll
  for (int r = 0; r < 16; ++r) { int orow = crow(r, hi);
#pragma unroll
    for (int d0 = 0; d0 < 4; ++d0) { const float val = o[d0][r] * rli[r];
      if constexpr (sizeof(TO) == 4) Ow[(long)orow * ldo + d0 * 32 + r32] = val; else Ow[(long)orow * ldo + d0 * 32 + r32] = (TO)f2bf(val); } }
  }
  __syncthreads();
#undef SLOAD
#undef SWRITE
#undef SWAIT
#undef RESC
}
}

namespace chk {
using att::crow; using att::v_st; using att::v_rd_base; using att::v_rd_off;
struct Cfg {
    const bf16_t* Z; int ld;
    int qcol, kcol, vcol, gcol;
    const float* BF; const float* BB;
    const float* dec_f; const float* dec_b;
    float qscale;
    bf16_t* U;
    bf16_t* OUT; int ldo; int ocol;
    const float* gain;
};
__device__ __forceinline__ s16x4 vtr(const LAS char* p) { return __builtin_bit_cast(s16x4, __builtin_amdgcn_ds_read_tr16_b64_v4i16((LAS v4i16_t*)p)); }
__device__ __forceinline__ bf16x8 trfrag(const LAS char* base, int d0, int ks) {
    const s16x4 l = vtr(base + v_rd_off(d0, ks, 0)), h = vtr(base + v_rd_off(d0, ks, 1));
    return (bf16x8){l[0], l[1], l[2], l[3], h[0], h[1], h[2], h[3]};
}
__device__ __forceinline__ void unpack8w(const u32x4 w, float* f) { f[0] = bflo(w.x); f[1] = bfhi(w.x); f[2] = bflo(w.y); f[3] = bfhi(w.y); f[4] = bflo(w.z); f[5] = bfhi(w.z); f[6] = bflo(w.w); f[7] = bfhi(w.w); }
__device__ __forceinline__ u32x4 scale8(u32x4 w, const float* s) {
    u32x4 o; o.x = cvtpk(bflo(w.x) * s[0], bfhi(w.x) * s[1]); o.y = cvtpk(bflo(w.y) * s[2], bfhi(w.y) * s[3]);
    o.z = cvtpk(bflo(w.z) * s[4], bfhi(w.z) * s[5]); o.w = cvtpk(bflo(w.w) * s[6], bfhi(w.w) * s[7]); return o;
}
__device__ __forceinline__ u32x4 scale8s(u32x4 w, float s) {
    u32x4 o; o.x = cvtpk(bflo(w.x) * s, bfhi(w.x) * s); o.y = cvtpk(bflo(w.y) * s, bfhi(w.y) * s);
    o.z = cvtpk(bflo(w.z) * s, bfhi(w.z) * s); o.w = cvtpk(bflo(w.w) * s, bfhi(w.w) * s); return o;
}

template <int DK, bool RET>
__device__ __forceinline__ void chunk_states(const Cfg& cf, char* lds, int unit, int WV_) {
    const int tid = otid(), wid = tid >> 6, lane = tid & 63, r32 = lane & 31, hi = lane >> 5;
    const int b = unit >> 7, c = unit & 127; const long row_base = (long)b * SEQ + (long)c * 64;
    constexpr int KG = DK / 8;
    const LAS char* L = (const LAS char*)lds;
    for (int hp = 0; hp < 2; ++hp) {
#pragma unroll
        for (int i = 0; i < 4; ++i) { const int p = tid + 512 * i, hl = p >> 10, row = (p >> 4) & 63, cg = p & 15, h = hp * 2 + hl;
            const bf16x8 v = att::ld8(cf.Z + (row_base + row) * cf.ld + cf.vcol + h * 128 + cg * 8);
            *(bf16x8*)(lds + hl * 16384 + v_st(row, cg * 8)) = v; }
#pragma unroll
        for (int i = 0; i < (2 * 64 * KG) / 512; ++i) { const int p = tid + 512 * i, hl = p / (64 * KG), row = (p / KG) % 64, cg = p % KG, h = hp * 2 + hl;
            const u32x4 kw = *(const u32x4*)(cf.Z + (row_base + row) * cf.ld + cf.kcol + h * DK + cg * 8);
            u32x4 kf, kb;
            if constexpr (RET) { const float laf = -__expf(cf.dec_f[h]), lab = -__expf(cf.dec_b[h]);
                kf = scale8s(kw, __expf((float)(63 - row) * laf)); kb = scale8s(kw, __expf((float)row * lab)); }
            else { const int col = h * 64 + cg * 8; float wf[8], wb[8];
                const f32x4 fl0 = *(const f32x4*)(cf.BF + (row_base + 63) * 256 + col), fl1 = *(const f32x4*)(cf.BF + (row_base + 63) * 256 + col + 4);
                const f32x4 fs0 = *(const f32x4*)(cf.BF + (row_base + row) * 256 + col), fs1 = *(const f32x4*)(cf.BF + (row_base + row) * 256 + col + 4);
                const f32x4 bl0 = *(const f32x4*)(cf.BB + row_base * 256 + col), bl1 = *(const f32x4*)(cf.BB + row_base * 256 + col + 4);
                const f32x4 bs0 = *(const f32x4*)(cf.BB + (row_base + row) * 256 + col), bs1 = *(const f32x4*)(cf.BB + (row_base + row) * 256 + col + 4);
#pragma unroll
                for (int j = 0; j < 4; ++j) { wf[j] = __expf(fl0[j] - fs0[j]); wf[4 + j] = __expf(fl1[j] - fs1[j]); wb[j] = __expf(bl0[j] - bs0[j]); wb[4 + j] = __expf(bl1[j] - bs1[j]); }
                kf = scale8(kw, wf); kb = scale8(kw, wb); }
            *(u32x4*)(lds + 32768 + hl * 16384 + v_st(row, cg * 8)) = kf;
            *(u32x4*)(lds + 65536 + hl * 16384 + v_st(row, cg * 8)) = kb; }
        __syncthreads();
        {
            const int hl = wid >> 2, dir = (wid >> 1) & 1, vh = wid & 1, h = hp * 2 + hl;
            const LAS char* vbV = L + hl * 16384 + v_rd_base(lane);
            const LAS char* vbK = L + 32768 + dir * 32768 + hl * 16384 + v_rd_base(lane);
            bf16_t* Ub = cf.U + ((((size_t)(b * 128 + c) * 4 + h) * 2 + dir) * 128) * DK;
#pragma unroll
            for (int ii = 0; ii < 2; ++ii) {
                f32x16 acc[DK / 32];
#pragma unroll
                for (int j = 0; j < DK / 32; ++j) acc[j] = f32x16{};
#pragma unroll
                for (int ks = 0; ks < 4; ++ks) {
                    const bf16x8 af = trfrag(vbV, vh * 2 + ii, ks);
#pragma unroll
                    for (int j = 0; j < DK / 32; ++j) { const bf16x8 bfr = trfrag(vbK, j, ks); acc[j] = __builtin_amdgcn_mfma_f32_32x32x16_bf16(af, bfr, acc[j], 0, 0, 0); }
                }
#pragma unroll
                for (int j = 0; j < DK / 32; ++j)
#pragma unroll
                    for (int r = 0; r < 16; ++r) Ub[(size_t)(32 * (vh * 2 + ii) + crow(r, hi)) * DK + 32 * j + r32] = f2bf(acc[j][r]);
                SBAR();
            }
        }
        __syncthreads();
    }
}

template <int DK, bool RET>
__device__ __forceinline__ void chunk_scan(const Cfg& cf, int chain) {
    constexpr int KH = DK / 2, NCH = 2 * 4 * 2 * 128 * KH;
    if (chain >= NCH) return;
    const int k2 = chain % KH, v = (chain / KH) % 128, dir = (chain / (KH * 128)) % 2, h = (chain / (KH * 256)) % 4, b = chain / (KH * 1024);
    const size_t cstride = (size_t)4 * 2 * 128 * DK;
    bf16_t* base = cf.U + ((((size_t)(b * 128) * 4 + h) * 2 + dir) * 128 + v) * DK + k2 * 2;
    float s0 = 0.f, s1 = 0.f, dsc = 0.f;
    if constexpr (RET) dsc = __expf(-64.f * __expf(dir ? cf.dec_b[h] : cf.dec_f[h]));
    constexpr int PF = 32;
    for (int c0 = 0; c0 < 128; c0 += PF) {
        unsigned u[PF]; f32x2 d[PF];
#pragma unroll
        for (int i = 0; i < PF; ++i) { const int c = dir ? (127 - c0 - i) : (c0 + i);
            u[i] = *(const unsigned*)(base + (size_t)c * cstride);
            if constexpr (!RET) d[i] = *(const f32x2*)((dir ? cf.BB + ((long)b * SEQ + c * 64) * 256 : cf.BF + ((long)b * SEQ + c * 64 + 63) * 256) + h * 64 + k2 * 2); }
#pragma unroll
        for (int i = 0; i < PF; ++i) { const int c = dir ? (127 - c0 - i) : (c0 + i);
            *(unsigned*)(base + (size_t)c * cstride) = cvtpk(s0, s1);
            float dd0 = dsc, dd1 = dsc;
            if constexpr (!RET) { dd0 = __expf(d[i][0]); dd1 = __expf(d[i][1]); }
            s0 = fmaf(dd0, s0, bflo(u[i])); s1 = fmaf(dd1, s1, bfhi(u[i])); }
    }
}

template <int DK, bool RET>
__device__ __forceinline__ void chunk_out(const Cfg& cf, char* lds, int unit, int WV_) {
    const int tid = otid(), wid = tid >> 6, lane = tid & 63, r32 = lane & 31, hi = lane >> 5;
    const int b = unit >> 7, c = unit & 127; const long row_base = (long)b * SEQ + (long)c * 64;
    constexpr int KG = DK / 8, ND0 = DK / 16, NKP = (4 * 64 * KG) / 512;
    {
        bf16x8 vv[8];
#pragma unroll
        for (int i = 0; i < 8; ++i) { const int p = tid + 512 * i, h = p >> 10, row = (p >> 4) & 63, cg = p & 15; vv[i] = att::ld8(cf.Z + (row_base + row) * cf.ld + cf.vcol + h * 128 + cg * 8); }
#pragma unroll
        for (int i = 0; i < 8; ++i) { const int p = tid + 512 * i, h = p >> 10, row = (p >> 4) & 63, cg = p & 15; *(bf16x8*)(lds + h * 16384 + v_st(row, cg * 8)) = vv[i]; }
    }
    {
        u32x4 kw[NKP];
#pragma unroll
        for (int i = 0; i < NKP; ++i) { const int p = tid + 512 * i, h = p / (64 * KG), row = (p / KG) % 64, cg = p % KG; kw[i] = *(const u32x4*)(cf.Z + (row_base + row) * cf.ld + cf.kcol + h * DK + cg * 8); }
        if constexpr (RET) {
#pragma unroll
            for (int i = 0; i < NKP; ++i) { const int p = tid + 512 * i, h = p / (64 * KG), row = (p / KG) % 64, cg = p % KG; *(u32x4*)(lds + 65536 + h * 16384 + KSWZ(row, cg * 16)) = kw[i]; }
        } else {
            f32x4 fs[NKP][2], bs[NKP][2];
#pragma unroll
            for (int i = 0; i < NKP; ++i) { const int p = tid + 512 * i, h = p / (64 * KG), row = (p / KG) % 64, cg = p % KG, col = h * 64 + cg * 8;
                fs[i][0] = *(const f32x4*)(cf.BF + (row_base + row) * 256 + col); fs[i][1] = *(const f32x4*)(cf.BF + (row_base + row) * 256 + col + 4);
                bs[i][0] = *(const f32x4*)(cf.BB + (row_base + row) * 256 + col); bs[i][1] = *(const f32x4*)(cf.BB + (row_base + row) * 256 + col + 4); }
#pragma unroll
            for (int i = 0; i < NKP; ++i) { const int p = tid + 512 * i, h = p / (64 * KG), row = (p / KG) % 64, cg = p % KG; float wf[8], wb[8];
#pragma unroll
                for (int jj = 0; jj < 4; ++jj) { wf[jj] = __expf(-fs[i][0][jj]); wf[4 + jj] = __expf(-fs[i][1][jj]); wb[jj] = __expf(-bs[i][0][jj]); wb[4 + jj] = __expf(-bs[i][1][jj]); }
                *(u32x4*)(lds + 65536 + h * 8192 + KSWZ64(row, cg * 16)) = scale8(kw[i], wf);
                *(u32x4*)(lds + 98304 + h * 8192 + KSWZ64(row, cg * 16)) = scale8(kw[i], wb); }
        }
    }
    __syncthreads();
    const int h = wid >> 1, rh = wid & 1, t = rh * 32 + r32;
    const long grow = row_base + t;
    bf16x8 qr[ND0];
#pragma unroll
    for (int d0 = 0; d0 < ND0; ++d0) qr[d0] = att::ld8(cf.Z + grow * cf.ld + cf.qcol + h * DK + d0 * 16 + hi * 8);
    f32x16 o[4] = {};
    float laf = 0.f, lab = 0.f;
    if constexpr (RET) { laf = -__expf(cf.dec_f[h]); lab = -__expf(cf.dec_b[h]); }
    bf16x8 qf[RET ? 1 : ND0], qb[RET ? 1 : ND0];
    if constexpr (!RET) {
#pragma unroll
        for (int d0 = 0; d0 < ND0; ++d0) { const int col = h * 64 + d0 * 16 + hi * 8; float ef[8], eb[8];
            const f32x4 f0 = *(const f32x4*)(cf.BF + grow * 256 + col), f1 = *(const f32x4*)(cf.BF + grow * 256 + col + 4);
            const f32x4 b0 = *(const f32x4*)(cf.BB + grow * 256 + col), b1 = *(const f32x4*)(cf.BB + grow * 256 + col + 4);
#pragma unroll
            for (int jj = 0; jj < 4; ++jj) { ef[jj] = __expf(f0[jj]) * cf.qscale; ef[4 + jj] = __expf(f1[jj]) * cf.qscale; eb[jj] = __expf(b0[jj]) * cf.qscale; eb[4 + jj] = __expf(b1[jj]) * cf.qscale; }
            const u32x4 qw = __builtin_bit_cast(u32x4, qr[d0]);
            qf[d0] = __builtin_bit_cast(bf16x8, scale8(qw, ef)); qb[d0] = __builtin_bit_cast(bf16x8, scale8(qw, eb)); }
    }
#pragma unroll
    for (int dir = 0; dir < 2; ++dir) {
        const bf16_t* Sb = cf.U + ((((size_t)(b * 128 + c) * 4 + h) * 2 + dir) * 128) * DK;
        float rs = 1.f;
        if constexpr (RET) rs = dir ? __expf((float)(64 - t) * lab) : __expf((float)(t + 1) * laf);
#pragma unroll
        for (int d2 = 0; d2 < ND0; d2 += 2) {
            bf16x8 bfr[2][4];
#pragma unroll
            for (int dd = 0; dd < 2; ++dd)
#pragma unroll
                for (int jv = 0; jv < 4; ++jv) bfr[dd][jv] = att::ld8(Sb + (size_t)(32 * jv + r32) * DK + (d2 + dd) * 16 + hi * 8);
#pragma unroll
            for (int dd = 0; dd < 2; ++dd) { const int d0 = d2 + dd; bf16x8 a;
                if constexpr (RET) a = __builtin_bit_cast(bf16x8, scale8s(__builtin_bit_cast(u32x4, qr[d0]), rs));
                else a = dir ? qb[d0] : qf[d0];
#pragma unroll
                for (int jv = 0; jv < 4; ++jv) o[jv] = __builtin_amdgcn_mfma_f32_32x32x16_bf16(a, bfr[dd][jv], o[jv], 0, 0, 0); }
            SBAR();
        }
    }
    f32x16 p0, p1;
    if constexpr (RET) {
        att::qkt<0, 8>(p0, p1, (const bf16_t*)(lds + 65536 + h * 16384), qr, r32, hi);
#pragma unroll
        for (int r = 0; r < 16; ++r) { const int s0 = crow(r, hi), s1 = 32 + s0;
            p0[r] *= (s0 <= t) ? __expf((float)(t - s0) * laf) : __expf((float)(s0 - t) * lab);
            p1[r] *= (s1 <= t) ? __expf((float)(t - s1) * laf) : __expf((float)(s1 - t) * lab); }
    } else {
        f32x16 q0, q1;
        att::qkt64(p0, p1, (const bf16_t*)(lds + 65536 + h * 8192), qf, r32, hi);
        att::qkt64(q0, q1, (const bf16_t*)(lds + 98304 + h * 8192), qb, r32, hi);
#pragma unroll
        for (int r = 0; r < 16; ++r) { const int s0 = crow(r, hi), s1 = 32 + s0;
            p0[r] = (s0 <= t) ? p0[r] : q0[r]; p1[r] = (s1 <= t) ? p1[r] : q1[r]; }
    }
    bf16x8 pa0, pa1, pa2, pa3;
    PK4(p0, 0, pa0); PK4(p0, 8, pa1); PK4(p1, 0, pa2); PK4(p1, 8, pa3);
    att::pv_d0(o, (int)(uintptr_t)lds + h * 16384 + v_rd_base(lane), pa0, pa1, pa2, pa3);
    float gn[4] = {1.f, 1.f, 1.f, 1.f};
    if constexpr (!RET) {
#pragma unroll
        for (int jv = 0; jv < 4; ++jv) gn[jv] = cf.gain[32 * jv + r32];
    }
    __syncthreads();
    bf16_t* Yt = (bf16_t*)(lds + 65536 + h * 16384);
#pragma unroll
    for (int r = 0; r < 16; ++r) { const int orow = rh * 32 + crow(r, hi);
        float y[4];
        if constexpr (RET) {
            const float mu = half_sum((o[0][r] + o[1][r]) + (o[2][r] + o[3][r])) * (1.f / 128.f);
            float q = 0.f;
#pragma unroll
            for (int jv = 0; jv < 4; ++jv) { y[jv] = o[jv][r] - mu; q += y[jv] * y[jv]; }
            const float rstd = 1.f / sqrtf(half_sum(q) * (1.f / 128.f) + 1e-5f);
#pragma unroll
            for (int jv = 0; jv < 4; ++jv) y[jv] *= rstd;
        } else {
            float q = 0.f;
#pragma unroll
            for (int jv = 0; jv < 4; ++jv) q += o[jv][r] * o[jv][r];
            const float rstd = 1.f / sqrtf(half_sum(q) * (1.f / 128.f) + 1e-6f);
#pragma unroll
            for (int jv = 0; jv < 4; ++jv) y[jv] = o[jv][r] * rstd * gn[jv];
        }
#pragma unroll
        for (int jv = 0; jv < 4; ++jv) Yt[orow * 128 + 32 * jv + r32] = f2bf(y[jv]);
    }
    __syncthreads();
    {
        const int tid2 = otid();
        u32x4 gw8[8];
#pragma unroll
        for (int i = 0; i < 8; ++i) { const int p = tid2 + 512 * i, hh = p >> 10, row = (p >> 4) & 63, cg = p & 15; gw8[i] = *(const u32x4*)(cf.Z + (row_base + row) * cf.ld + cf.gcol + hh * 128 + cg * 8); }
#pragma unroll
        for (int i = 0; i < 8; ++i) { const int p = tid2 + 512 * i, hh = p >> 10, row = (p >> 4) & 63, cg = p & 15;
            const u32x4 yw = *(const u32x4*)(lds + 65536 + hh * 16384 + row * 256 + cg * 16);
            float yf[8], gf[8]; unpack8w(yw, yf); unpack8w(gw8[i], gf);
#pragma unroll
            for (int e = 0; e < 8; ++e) yf[e] *= silu_f(gf[e]);
            u32x4 ow; ow.x = cvtpk(yf[0], yf[1]); ow.y = cvtpk(yf[2], yf[3]); ow.z = cvtpk(yf[4], yf[5]); ow.w = cvtpk(yf[6], yf[7]);
            *(u32x4*)(cf.OUT + (row_base + row) * cf.ldo + cf.ocol + hh * 128 + cg * 8) = ow; }
    }
    __syncthreads();
}
}

#define XB_TMO      128
#define XB_XCNT(j)  (256  + 64 * (j))
#define XB_XSUB(j)  (1280 + 64 * (j))
#define XB_XGEN(j)  (2304 + 64 * (j))
#define XB_TOP      3328
#define XB_TOPGEN   3392
#define XCD_BAR_WORDS 3456
#define XB_SPIN_CAP (1u << 18)
__device__ __forceinline__ unsigned xb_ld(unsigned* p)              { return __hip_atomic_load(p, __ATOMIC_RELAXED, __HIP_MEMORY_SCOPE_AGENT); }
__device__ __forceinline__ unsigned xb_add(unsigned* p, unsigned v) { return __hip_atomic_fetch_add(p, v, __ATOMIC_RELAXED, __HIP_MEMORY_SCOPE_AGENT); }
__device__ __forceinline__ unsigned xb_xcc_id() { return (unsigned)__builtin_amdgcn_s_getreg((3 << 11) | 20) & 0xFu; }
#define XB_SPIN(cond, bar) do { unsigned _sp = 0; while (cond) { __builtin_amdgcn_s_sleep(1); \
    if ((++_sp & 255u) == 0u) { if (xb_ld(&(bar)[XB_TMO])) break; if (_sp > XB_SPIN_CAP) { atomicAdd(&(bar)[XB_TMO], 1u); break; } } } } while (0)
struct XcdBarrier { unsigned* bar; unsigned x; volatile LAS unsigned* st; };
__device__ __forceinline__ XcdBarrier xcd_barrier_post(unsigned* bar, volatile LAS unsigned* st, int WV_) {
    XcdBarrier b; b.bar = bar; b.x = xb_xcc_id(); b.st = st;
    if (otid() == 0) (void)xb_add(&bar[XB_XCNT(b.x)], 1u);
    return b;
}
__device__ __forceinline__ void xcd_barrier_complete(unsigned* bar, unsigned x, unsigned& nloc, unsigned& nx) {
    const unsigned G = gridDim.x * gridDim.y * gridDim.z;
    unsigned sum, cnt, mine, sp = 0u;
    for (;;) {
        sum = 0u; cnt = 0u; mine = 0u;
#pragma unroll
        for (unsigned j = 0; j < 16; ++j) { const unsigned c = xb_ld(&bar[XB_XCNT(j)]); sum += c; cnt += (c > 0u) ? 1u : 0u; mine = (j == x) ? c : mine; }
        if (sum == G) break;
        __builtin_amdgcn_s_sleep(1);
        if ((++sp & 255u) == 0u) { if (xb_ld(&bar[XB_TMO])) break; if (sp > XB_SPIN_CAP) { atomicAdd(&bar[XB_TMO], 1u); break; } }
    }
    nloc = mine > 0u ? mine : 1u; nx = cnt > 0u ? cnt : 1u;
}
__device__ __forceinline__ void xcd_barrier(const XcdBarrier& b, int WV_) {
    asm volatile("s_waitcnt vmcnt(0)" ::: "memory");
    __syncthreads();
    if (otid() == 0) {
        unsigned* bar = b.bar;
        __builtin_amdgcn_s_waitcnt(0);
        unsigned nloc = b.st[0], nx = b.st[1];
        if (nloc == 0u) { xcd_barrier_complete(bar, b.x, nloc, nx); b.st[0] = nloc; b.st[1] = nx; }
        const unsigned old = xb_add(&bar[XB_XSUB(b.x)], 1u);
        const unsigned gen = old / nloc;
        if (old + 1u == (gen + 1u) * nloc) {
            __builtin_amdgcn_fence(__ATOMIC_RELEASE, "agent");
            asm volatile("s_waitcnt vmcnt(0)" ::: "memory");
            const unsigned og = xb_add(&bar[XB_TOP], 1u);
            const unsigned tg = og / nx;
            if (og + 1u == (tg + 1u) * nx) xb_add(&bar[XB_TOPGEN], 1u);
            else XB_SPIN(xb_ld(&bar[XB_TOPGEN]) == tg, bar);
            __builtin_amdgcn_fence(__ATOMIC_ACQUIRE, "agent");
            xb_add(&bar[XB_XGEN(b.x)], 1u);
            asm volatile("s_waitcnt vmcnt(0)" ::: "memory");
        } else {
            XB_SPIN(xb_ld(&bar[XB_XGEN(b.x)]) == gen, bar);
            __builtin_amdgcn_fence(__ATOMIC_ACQUIRE, "agent");
            asm volatile("s_waitcnt vmcnt(0)" ::: "memory");
        }
    }
    __syncthreads();
}

constexpr int NWAVES = 8;
constexpr int RING_BYTES = 131072, MISC_OFF = RING_BYTES + 320, LDS_BYTES = 147456;

struct Args { const float* in[32]; float* out; unsigned char* ws; int ph_lo, ph_hi; };
#define CAS __attribute__((address_space(4)))
#define KWS(A) ((unsigned char*)(((void* const volatile CAS*)__builtin_amdgcn_kernarg_segment_ptr())[33]))
#define KOUT(A) ((float*)(((void* const volatile CAS*)__builtin_amdgcn_kernarg_segment_ptr())[32]))
#define KARG(A, i) (((const float* const volatile CAS*)__builtin_amdgcn_kernarg_segment_ptr())[i])

template <class RowMap>
__device__ __forceinline__ void tr_item(const float* W, int ldw, int k0, int n0, bf16_t* WT, int ldk, const RowMap& rm, LAS float* scr, int lane, const float* gain = nullptr) {
    float tv[32];
#pragma unroll
    for (int i = 0; i < 32; ++i) { const int kk = 2 * i + (lane >> 5); tv[i] = __builtin_nontemporal_load(&W[(size_t)(k0 + kk) * ldw + n0 + (lane & 31)]); }
#pragma unroll
    for (int i = 0; i < 32; ++i) { const int kk = 2 * i + (lane >> 5); scr[kk * 33 + (lane & 31)] = tv[i]; }
    LDS_WAIT(); asm volatile("" ::: "memory");
    const int c = lane & 7;
    float gk[8];
#pragma unroll
    for (int e = 0; e < 8; ++e) gk[e] = gain ? gain[k0 + 8 * c + e] : 1.f;
#pragma unroll
    for (int j = 0; j < 4; ++j) { const int n = (lane >> 3) + 8 * j; const LAS float* s = scr + (8 * c) * 33 + n;
        u32x4 o; o.x = cvtpk(s[0 * 33] * gk[0], s[1 * 33] * gk[1]); o.y = cvtpk(s[2 * 33] * gk[2], s[3 * 33] * gk[3]); o.z = cvtpk(s[4 * 33] * gk[4], s[5 * 33] * gk[5]); o.w = cvtpk(s[6 * 33] * gk[6], s[7 * 33] * gk[7]);
        *(u32x4*)(WT + (size_t)rm(n0 + n) * ldk + k0 + 8 * c) = o; }
    LDS_WAIT(); asm volatile("" ::: "memory");
}
struct RmId { __device__ int operator()(int n) const { return n; } };
struct RmUq { __device__ int operator()(int n) const { const int h = n / 96, j = n % 96; if (j < 64) return h * 128 + j; const int i = j - 64; return h * 128 + 64 + ((i < 16) ? 2 * i : 2 * (i - 16) + 1); } };
struct RmUkv { __device__ int operator()(int n) const { const int h = n / 192, j = n % 192; return j < 64 ? h * 128 + j : 512 + h * 128 + (j - 64); } };
struct RmGU { int up; __device__ int operator()(int n) const { return (n >> 7) * 256 + up * 128 + (n & 127); } };

__device__ __forceinline__ void moe_weight_item(const Args& a, int layer, int r, LAS float* scr, int lane) {
    const int e = r / 768, q = r % 768;
    bf16_t* WGU = (bf16_t*)(KWS(a) + WS_WGU) + (size_t)e * 1024 * 1024; bf16_t* WDN = (bf16_t*)(KWS(a) + WS_WDN) + (size_t)e * 1024 * 512;
    const size_t eo = ((size_t)layer * 32 + e) * (size_t)(1024 * 512);
    if (q < 256) { tr_item(KARG(a, 29) + eo, 512, 64 * (q / 16), 32 * (q % 16), WGU, 1024, RmGU{0}, scr, lane); }
    else if (q < 512) { const int qq = q - 256; tr_item(KARG(a, 30) + eo, 512, 64 * (qq / 16), 32 * (qq % 16), WGU, 1024, RmGU{1}, scr, lane); }
    else { const int qq = q - 512; tr_item(KARG(a, 31) + eo, 1024, 64 * (qq / 32), 32 * (qq % 32), WDN, 512, RmId{}, scr, lane); }
}

__device__ __forceinline__ void p_prologue(const Args& a, char* lds, int vcu, int G, int WV_) {
    const int tid = otid(), lane = tid & 63, wave = tid >> 6;
    LAS float* scr = (LAS float*)((LAS char*)lds + wave * 16384);
    const int gw = vcu * NWAVES + wave, NGW = G * NWAVES;
    bf16_t* WIN0 = (bf16_t*)(KWS(a) + WS_WIN0); bf16_t* WOUT0 = (bf16_t*)(KWS(a) + WS_WOUT0); bf16_t* WIN1 = (bf16_t*)(KWS(a) + WS_WIN1); bf16_t* WOUT1 = (bf16_t*)(KWS(a) + WS_WOUT1);
    bf16_t* WUQ = (bf16_t*)(KWS(a) + WS_WUQ); bf16_t* WUKV = (bf16_t*)(KWS(a) + WS_WUKV);
    constexpr int I_IN0 = 16 * 112, I_OUT = 16 * 32, I_IN1 = 16 * 62, I_UQ = 4 * 12, I_UKV = 2 * 24, I_MOE = 32 * 768;
    constexpr int NITEMS = I_IN0 + 2 * I_OUT + I_IN1 + I_UQ + I_UKV + I_MOE;
    for (int it = gw; it < NITEMS; it += NGW) {
        int r = it;
        if (r < I_MOE) { moe_weight_item(a, 0, r, scr, lane); continue; } r -= I_MOE;
        if (r < I_IN0) { tr_item(KARG(a, 1), 3584, 64 * (r / 112), 32 * (r % 112), WIN0, 1024, RmId{}, scr, lane); continue; } r -= I_IN0;
        if (r < I_OUT) { tr_item(KARG(a, 9), 1024, 64 * (r / 32), 32 * (r % 32), WOUT0, 1024, RmId{}, scr, lane); continue; } r -= I_OUT;
        if (r < I_IN1) { tr_item(KARG(a, 10), 1984, 64 * (r / 62), 32 * (r % 62), WIN1, 1024, RmId{}, scr, lane); continue; } r -= I_IN1;
        if (r < I_OUT) { tr_item(KARG(a, 20), 1024, 64 * (r / 32), 32 * (r % 32), WOUT1, 1024, RmId{}, scr, lane); continue; } r -= I_OUT;
        if (r < I_UQ) { tr_item(KARG(a, 12), 384, 64 * (r / 12), 32 * (r % 12), WUQ, 256, RmUq{}, scr, lane, KARG(a, 11)); continue; } r -= I_UQ;
        tr_item(KARG(a, 14), 768, 64 * (r / 24), 32 * (r % 24), WUKV, 256, RmUkv{}, scr, lane, KARG(a, 13));
    }
    const int gt = vcu * 512 + tid, NT = G * 512;
    const u32x4 z4 = {0u, 0u, 0u, 0u};
    for (int i = gt; i < 64 * 128; i += NT) *(u32x4*)(WIN1 + (size_t)1984 * 1024 + (size_t)i * 8) = z4;
    for (int i = gt; i < 128 * 32; i += NT) { const int rr = i / 32, c8 = i % 32; *(u32x4*)(WUQ + (size_t)((rr / 32) * 128 + 96 + (rr % 32)) * 256 + c8 * 8) = z4; }
    for (int i = gt; i < 256 * 16; i += NT) { const int rr = i / 16, c8 = i % 16; *(u32x4*)(WUKV + (size_t)((rr / 64) * 128 + 64 + (rr % 64)) * 256 + c8 * 8) = z4; }
    for (int i = gt; i < 1024 * 16; i += NT) { const int rr = i / 16, c8 = i % 16; *(u32x4*)(WUKV + (size_t)rr * 256 + 128 + c8 * 8) = z4; }
    float* WR = (float*)(KWS(a) + WS_WR);
    for (int i = gt; i < 2 * 36 * 1024; i += NT) { const int l = i / (36 * 1024), j = (i / 1024) % 36, k = i % 1024;
        WR[i] = j < 4 ? KARG(a, 25)[((size_t)l * 1024 + k) * 4 + j] : KARG(a, 27)[((size_t)l * 1024 + k) * 32 + (j - 4)]; }
    float* TAB = (float*)(KWS(a) + WS_TAB);
    { const int P = NT / 88;
      if (gt < 88 * P) { const int q = gt % 88, p0 = gt / 88;
        double inv; float* tc; float* tsn; int stride, f;
        if (q < 64) { f = q; inv = pow(10000.0, -(double)q / 64.0); tc = TAB + TAB_COSR; tsn = TAB + TAB_SINR; stride = 64; }
        else if (q < 72) { f = q - 64; inv = pow(500000.0, -(double)f / 8.0); tc = TAB + TAB_COSD; tsn = TAB + TAB_SIND; stride = 8; }
        else { f = q - 72; inv = pow(500000.0, -(double)f / 16.0); tc = TAB + TAB_COSM; tsn = TAB + TAB_SINM; stride = 16; }
        for (int pos = p0; pos < SEQ; pos += P) { double sv, cv; sincos((double)pos * inv, &sv, &cv); tc[(size_t)pos * stride + f] = (float)cv; tsn[(size_t)pos * stride + f] = (float)sv; } } }
    bf16_t* XB = (bf16_t*)(KWS(a) + WS_XB); const float* x = KARG(a, 0);
    for (size_t i = gt; i < (size_t)NTOK * DM / 8; i += NT) { const f32x4 v0 = *(const f32x4*)(x + i * 8), v1 = *(const f32x4*)(x + i * 8 + 4);
        u32x4 o; o.x = cvtpk(v0[0], v0[1]); o.y = cvtpk(v0[2], v0[3]); o.z = cvtpk(v1[0], v1[1]); o.w = cvtpk(v1[2], v1[3]); *(u32x4*)(XB + i * 8) = o; }
}

__device__ __forceinline__ void rot8(u32x4& w1, u32x4& w2, const float* cs, const float* sn, float scale) {
    const f32x4 c0 = *(const f32x4*)cs, c1 = *(const f32x4*)(cs + 4), s0 = *(const f32x4*)sn, s1 = *(const f32x4*)(sn + 4);
    float a[8] = {bflo(w1.x), bfhi(w1.x), bflo(w1.y), bfhi(w1.y), bflo(w1.z), bfhi(w1.z), bflo(w1.w), bfhi(w1.w)};
    float b[8] = {bflo(w2.x), bfhi(w2.x), bflo(w2.y), bfhi(w2.y), bflo(w2.z), bfhi(w2.z), bflo(w2.w), bfhi(w2.w)};
    float cc[8] = {c0[0], c0[1], c0[2], c0[3], c1[0], c1[1], c1[2], c1[3]}, ss[8] = {s0[0], s0[1], s0[2], s0[3], s1[0], s1[1], s1[2], s1[3]};
    float ra[8], rb[8];
#pragma unroll
    for (int j = 0; j < 8; ++j) { ra[j] = (a[j] * cc[j] - b[j] * ss[j]) * scale; rb[j] = (b[j] * cc[j] + a[j] * ss[j]) * scale; }
    w1.x = cvtpk(ra[0], ra[1]); w1.y = cvtpk(ra[2], ra[3]); w1.z = cvtpk(ra[4], ra[5]); w1.w = cvtpk(ra[6], ra[7]);
    w2.x = cvtpk(rb[0], rb[1]); w2.y = cvtpk(rb[2], rb[3]); w2.z = cvtpk(rb[4], rb[5]); w2.w = cvtpk(rb[6], rb[7]);
}

__device__ __forceinline__ void p_rot0(const Args& a, int vcu, int G, int WV_) {
    const int tid = otid(), lane = tid & 63, wave = tid >> 6, gw = vcu * NWAVES + wave, NGW = G * NWAVES;
    bf16_t* Z = (bf16_t*)(KWS(a) + WS_Z); const float* TAB = (const float*)(KWS(a) + WS_TAB);
    const int tq = lane >> 5, h = (lane >> 3) & 3, i8 = lane & 7;
    const int drow = lane >> 4, dtq = (lane >> 3) & 1, dblk = lane & 7;
    for (int g = gw; g < NTOK / 4; g += NGW) { const int row0 = g * 4;
        u32x4 w1[5], w2[5]; bf16_t* p1[5];
#pragma unroll
        for (int i = 0; i < 4; ++i) { p1[i] = Z + (size_t)(row0 + i) * LDZ0 + tq * 512 + h * 128 + i8 * 8; w1[i] = *(u32x4*)p1[i]; w2[i] = *(u32x4*)(p1[i] + 64); }
        p1[4] = Z + (size_t)(row0 + drow) * LDZ0 + Z0_DQ + dtq * 512 + dblk * 64; w1[4] = *(u32x4*)p1[4]; w2[4] = *(u32x4*)(p1[4] + 8);
#pragma unroll
        for (int i = 0; i < 4; ++i) { const int pos = (row0 + i) & (SEQ - 1);
            rot8(w1[i], w2[i], TAB + TAB_COSR + (size_t)pos * 64 + i8 * 8, TAB + TAB_SINR + (size_t)pos * 64 + i8 * 8, tq ? 0.08838834764831845f : 1.f); }
        { const int pos = (row0 + drow) & (SEQ - 1); rot8(w1[4], w2[4], TAB + TAB_COSD + (size_t)pos * 8, TAB + TAB_SIND + (size_t)pos * 8, 1.f); }
#pragma unroll
        for (int i = 0; i < 4; ++i) { *(u32x4*)p1[i] = w1[i]; *(u32x4*)(p1[i] + 64) = w2[i]; }
        *(u32x4*)p1[4] = w1[4]; *(u32x4*)(p1[4] + 8) = w2[4];
    }
}

__device__ __forceinline__ void p_diffcomb(const Args& a, int vcu, int G, int WV_) {
    const int tid = otid(), lane = tid & 63, wave = tid >> 6, gw = vcu * NWAVES + wave, NGW = G * NWAVES;
    float s1 = KARG(a, 4)[lane] * KARG(a, 5)[lane], s2 = KARG(a, 6)[lane] * KARG(a, 7)[lane];
    s1 = wave_sum(s1); s2 = wave_sum(s2);
    const float lam_init = 0.2f;
    const float lam = (expf(s1) - expf(s2)) + lam_init;
    const float* OA = (const float*)(KWS(a) + WS_OAB); const float* OB = OA + (size_t)NTOK * 512; bf16_t* A2 = (bf16_t*)(KWS(a) + WS_A2);
    const float g0 = KARG(a, 8)[lane * 2], g1 = KARG(a, 8)[lane * 2 + 1];
    for (int t = gw; t < NTOK * 4; t += NGW) { const int row = t >> 2, h = t & 3; const size_t off = (size_t)row * 512 + h * 128 + lane * 2;
        const f32x2 va = *(const f32x2*)(OA + off), vb = *(const f32x2*)(OB + off);
        const float o0 = va[0] - lam * vb[0], o1 = va[1] - lam * vb[1];
        const float ms = wave_sum(o0 * o0 + o1 * o1) * (1.f / 128.f);
        const float rs = (1.f / sqrtf(ms + 1e-6f)) * (1.f - lam_init);
        *(unsigned*)(A2 + (size_t)row * 1024 + 512 + h * 128 + lane * 2) = cvtpk(o0 * rs * g0, o1 * rs * g1); }
}

__device__ __forceinline__ void unpack8(const u32x4 w, float* f) { f[0] = bflo(w.x); f[1] = bfhi(w.x); f[2] = bflo(w.y); f[3] = bfhi(w.y); f[4] = bflo(w.z); f[5] = bfhi(w.z); f[6] = bflo(w.w); f[7] = bfhi(w.w); }
__device__ __forceinline__ u32x4 pack8(const float* f) { u32x4 w; w.x = cvtpk(f[0], f[1]); w.y = cvtpk(f[2], f[3]); w.z = cvtpk(f[4], f[5]); w.w = cvtpk(f[6], f[7]); return w; }
__device__ __forceinline__ void ln_row16(float* v, const float* gv, const float* bv) {
    float s = 0.f;
#pragma unroll
    for (int i = 0; i < 16; ++i) s += v[i];
    const float mean = wave_sum(s) * (1.f / 1024.f); float q = 0.f;
#pragma unroll
    for (int i = 0; i < 16; ++i) { v[i] -= mean; q += v[i] * v[i]; }
    const float rstd = 1.f / sqrtf(wave_sum(q) * (1.f / 1024.f) + LN_EPS);
#pragma unroll
    for (int i = 0; i < 16; ++i) v[i] = v[i] * rstd * gv[i] + bv[i];
}
template <bool XF32>
__device__ __forceinline__ void p_ln1_router(const Args& a, char* lds, int vcu, int G, int layer, const void* xprev, int WV_) {
    const int tid = otid(), lane = tid & 63, wave = tid >> 6, gw = vcu * NWAVES + wave, NGW = G * NWAVES;
    const bf16_t* Yb = (const bf16_t*)(KWS(a) + WS_Y); bf16_t* XBp = (bf16_t*)(KWS(a) + WS_XB);
    const float* gam = KARG(a, 21) + layer * 1024; const float* bet = KARG(a, 22) + layer * 1024;
    const float* WR = (const float*)(KWS(a) + WS_WR) + (size_t)layer * 36 * 1024;
    unsigned* cnt = (unsigned*)(KWS(a) + WS_CNTB);
    int4* asg = (int4*)(KWS(a) + WS_ASG);
    LAS float* lg = (LAS float*)((LAS char*)lds + wave * 2048);
    LAS unsigned* lcnt = (LAS unsigned*)((LAS char*)lds + 16384);
    if (tid < 32) lcnt[tid] = 0u;
    __syncthreads();
    float gv[16], bv[16];
#pragma unroll
    for (int j = 0; j < 2; ++j)
#pragma unroll
        for (int q = 0; q < 2; ++q) { const f32x4 g4 = *(const f32x4*)(gam + 8 * lane + 512 * j + 4 * q), b4 = *(const f32x4*)(bet + 8 * lane + 512 * j + 4 * q);
#pragma unroll
            for (int e = 0; e < 4; ++e) { gv[j * 8 + q * 4 + e] = g4[e]; bv[j * 8 + q * 4 + e] = b4[e]; } }
    const int rbit = 4 * (lane & 1) + 2 * ((lane >> 1) & 1) + ((lane >> 2) & 1);
    for (int g8 = gw; g8 < NTOK / 8; g8 += NGW) {
        float xn[8][16];
#pragma unroll
        for (int half = 0; half < 2; ++half) {
            u32x4 yb[4][2];
#pragma unroll
            for (int r4 = 0; r4 < 4; ++r4) { const int rr = half * 4 + r4; const size_t ro = (size_t)(g8 * 8 + rr) * 1024 + 8 * lane;
#pragma unroll
                for (int j = 0; j < 2; ++j) {
                    if constexpr (XF32) { const f32x4 x0 = *(const f32x4*)((const float*)xprev + ro + 512 * j), x1 = *(const f32x4*)((const float*)xprev + ro + 512 * j + 4);
#pragma unroll
                        for (int e = 0; e < 4; ++e) { xn[rr][j * 8 + e] = x0[e]; xn[rr][j * 8 + 4 + e] = x1[e]; } }
                    else { const u32x4 xw = *(const u32x4*)((const bf16_t*)xprev + ro + 512 * j); unpack8(xw, &xn[rr][j * 8]); }
                    yb[r4][j] = *(const u32x4*)(Yb + ro + 512 * j); } }
#pragma unroll
            for (int r4 = 0; r4 < 4; ++r4) { const int rr = half * 4 + r4; const size_t ro = (size_t)(g8 * 8 + rr) * 1024 + 8 * lane;
#pragma unroll
                for (int j = 0; j < 2; ++j) { float yf[8]; unpack8(yb[r4][j], yf);
#pragma unroll
                    for (int e = 0; e < 8; ++e) xn[rr][j * 8 + e] = xn[rr][j * 8 + e] * ALPHA + yf[e]; }
                ln_row16(xn[rr], gv, bv);
#pragma unroll
                for (int j = 0; j < 2; ++j) *(u32x4*)(XBp + ro + 512 * j) = pack8(&xn[rr][j * 8]); }
        }
#define RT_LOAD(W, J) do { _Pragma("unroll") for (int j = 0; j < 4; ++j) W[j] = *(const f32x4*)(WR + (size_t)(J) * 1024 + 8 * lane + 512 * (j >> 1) + 4 * (j & 1)); } while (0)
#define RT_STEP(W, J) do { float ps[8]; \
            _Pragma("unroll") for (int rr = 0; rr < 8; ++rr) { float s = 0.f; \
                _Pragma("unroll") for (int j = 0; j < 4; ++j) _Pragma("unroll") for (int e = 0; e < 4; ++e) s = fmaf(xn[rr][j * 4 + e], W[j][e], s); \
                ps[rr] = s; } \
            float n1[4], n2[2]; \
            _Pragma("unroll") for (int i = 0; i < 4; ++i) { const float send = b0 ? ps[i] : ps[i + 4], keep = b0 ? ps[i + 4] : ps[i]; n1[i] = keep + __shfl_xor(send, 1); } \
            _Pragma("unroll") for (int i = 0; i < 2; ++i) { const float send = b1 ? n1[i] : n1[i + 2], keep = b1 ? n1[i + 2] : n1[i]; n2[i] = keep + __shfl_xor(send, 2); } \
            float tot; { const float send = b2 ? n2[0] : n2[1], keep = b2 ? n2[1] : n2[0]; tot = keep + __shfl_xor(send, 4); } \
            tot += __shfl_xor(tot, 8); tot += __shfl_xor(tot, 16); tot += __shfl_xor(tot, 32); \
            if (lane < 8) lg[rbit * 40 + (J)] = tot; } while (0)
        { const bool b0 = lane & 1, b1 = lane & 2, b2 = lane & 4;
          f32x4 wvA[4], wvB[4];
          RT_LOAD(wvA, 0);
          for (int jo = 0; jo < 36; jo += 2) {
              RT_LOAD(wvB, jo + 1);
              RT_STEP(wvA, jo);
              if (jo + 2 < 36) RT_LOAD(wvA, jo + 2);
              RT_STEP(wvB, jo + 1); } }
#undef RT_LOAD
#undef RT_STEP
        LDS_WAIT(); asm volatile("" ::: "memory");
        if (lane < 8) { const int row = g8 * 8 + lane; const LAS float* l = lg + lane * 40;
            float gl[4]; int gi = 0;
#pragma unroll
            for (int j = 0; j < 4; ++j) gl[j] = l[j] + KARG(a, 26)[layer * 4 + j];
            float gm = gl[0];
#pragma unroll
            for (int j = 1; j < 4; ++j) if (gl[j] > gm) { gm = gl[j]; gi = j; }
            float den = 0.f;
#pragma unroll
            for (int j = 0; j < 4; ++j) den += expf(gl[j] - gm);
            const float pg = 1.f / den;
            float l1 = -3.0e38f, l2 = -3.0e38f; int i1 = 0, i2 = 0;
            for (int j = 0; j < 8; ++j) { const float v = l[4 + gi * 8 + j] + KARG(a, 28)[layer * 32 + gi * 8 + j];
                if (v > l1) { l2 = l1; i2 = i1; l1 = v; i1 = j; } else if (v > l2) { l2 = v; i2 = j; } }
            const float e2 = expf(l2 - l1), w1 = 1.f / (1.f + e2), w2 = e2 * w1;
            const int e1i = gi * 8 + i1, e2i = gi * 8 + i2;
            const unsigned sl1 = __hip_atomic_fetch_add(lcnt + e1i, 1u, __ATOMIC_RELAXED, __HIP_MEMORY_SCOPE_WORKGROUP), sl2 = __hip_atomic_fetch_add(lcnt + e2i, 1u, __ATOMIC_RELAXED, __HIP_MEMORY_SCOPE_WORKGROUP);
            asg[row * 2 + 0] = make_int4(e1i, (int)sl1, __float_as_int(pg * w1), (int)blockIdx.x);
            asg[row * 2 + 1] = make_int4(e2i, (int)sl2, __float_as_int(pg * w2), (int)blockIdx.x); }
        LDS_WAIT(); asm volatile("" ::: "memory");
    }
    __syncthreads();
    if (tid < 32) cnt[(size_t)blockIdx.x * 32 + tid] = lcnt[tid];
}

__device__ __forceinline__ void p_moe_scatter(const Args& a, char* lds, int vcu, int G, int layer, int WV_) {
    const int tid = otid(), lane = tid & 63, wave = tid >> 6, gw = vcu * NWAVES + wave, NGW = G * NWAVES;
    const unsigned* cntb = (const unsigned*)(KWS(a) + WS_CNTB);
    LAS int* off = (LAS int*)((LAS char*)lds);
    LAS unsigned short* pb = (LAS unsigned short*)((LAS char*)lds + 1024);
    {
        const int e = tid >> 4, s = tid & 15; unsigned c[16]; unsigned run = 0;
#pragma unroll
        for (int i = 0; i < 16; ++i) { const int b = s * 16 + i; c[i] = (b < G) ? cntb[(size_t)b * 32 + e] : 0u; }
        LAS unsigned* seg = (LAS unsigned*)((LAS char*)lds + 20480);
#pragma unroll
        for (int i = 0; i < 16; ++i) run += c[i];
        seg[e * 16 + s] = run;
        __syncthreads();
        unsigned base = 0; for (int q = 0; q < s; ++q) base += seg[e * 16 + q];
#pragma unroll
        for (int i = 0; i < 16; ++i) { const int b = s * 16 + i; if (b < G) pb[b * 32 + e] = (unsigned short)base; base += c[i]; }
        if (s == 15) off[40 + e] = (int)base;
        __syncthreads();
        if (tid == 0) { int o = 0; for (int q = 0; q < 32; ++q) { off[q] = o; o += (off[40 + q] + 255) & ~255; } off[32] = o; }
        __syncthreads();
    }
    const int4* asg = (const int4*)(KWS(a) + WS_ASG); int2* rowinfo = (int2*)(KWS(a) + WS_ROWINFO); int* tiles = (int*)(KWS(a) + WS_TILES);
    for (int as = vcu * 512 + tid; as < NTOK * 2; as += G * 512) { const int4 q = asg[as]; const int dest = off[q.x] + (int)pb[q.w * 32 + q.x] + q.y; rowinfo[dest] = make_int2(as, q.z); }
    if (blockIdx.x < 32) { const int e = blockIdx.x; const int c = off[40 + e];
        for (int r = off[e] + c + tid; r < off[e + 1]; r += 512) rowinfo[r] = make_int2(-1, 0); }
    if (blockIdx.x == 32 && tid < 64) { const int nt = off[32] >> 8; if (tid == 0) tiles[0] = nt;
        for (int t = tid; t < nt; t += 64) { int e = 0; for (int jj = 1; jj < 32; ++jj) if (off[jj] <= t * 256) e = jj; tiles[1 + t] = e; } }
    __syncthreads();
}

template <bool FINAL>
__device__ __forceinline__ void p_ln2(const Args& a, int vcu, int G, int layer, float* xout, int WV_) {
    const int tid = otid(), lane = tid & 63, wave = tid >> 6, gw = vcu * NWAVES + wave, NGW = G * NWAVES;
    const bf16_t* YS = (const bf16_t*)(KWS(a) + WS_YS); bf16_t* XBp = (bf16_t*)(KWS(a) + WS_XB);
    const float* gam = KARG(a, 23) + layer * 1024; const float* bet = KARG(a, 24) + layer * 1024;
    float gv[16], bv[16];
#pragma unroll
    for (int j = 0; j < 2; ++j)
#pragma unroll
        for (int q = 0; q < 2; ++q) { const f32x4 g4 = *(const f32x4*)(gam + 8 * lane + 512 * j + 4 * q), b4 = *(const f32x4*)(bet + 8 * lane + 512 * j + 4 * q);
#pragma unroll
            for (int e = 0; e < 4; ++e) { gv[j * 8 + q * 4 + e] = g4[e]; bv[j * 8 + q * 4 + e] = b4[e]; } }
    for (int g8 = gw; g8 < NTOK / 4; g8 += NGW) {
        u32x4 xw[4][2], y0[4][2], y1[4][2];
#pragma unroll
        for (int rr = 0; rr < 4; ++rr) { const size_t ro = (size_t)(g8 * 4 + rr) * 1024 + 8 * lane;
#pragma unroll
            for (int j = 0; j < 2; ++j) { xw[rr][j] = *(const u32x4*)(XBp + ro + 512 * j); y0[rr][j] = *(const u32x4*)(YS + ro + 512 * j); y1[rr][j] = *(const u32x4*)(YS + (size_t)NTOK * 1024 + ro + 512 * j); } }
#pragma unroll
        for (int rr = 0; rr < 4; ++rr) { const size_t ro = (size_t)(g8 * 4 + rr) * 1024 + 8 * lane; float v[16];
#pragma unroll
            for (int j = 0; j < 2; ++j) { float xf[8], a0[8], a1[8]; unpack8(xw[rr][j], xf); unpack8(y0[rr][j], a0); unpack8(y1[rr][j], a1);
#pragma unroll
                for (int e = 0; e < 8; ++e) v[j * 8 + e] = xf[e] * ALPHA + (a0[e] + a1[e]); }
            ln_row16(v, gv, bv);
#pragma unroll
            for (int j = 0; j < 2; ++j) {
                if constexpr (FINAL) { *(f32x4*)(xout + ro + 512 * j) = (f32x4){v[j * 8], v[j * 8 + 1], v[j * 8 + 2], v[j * 8 + 3]}; *(f32x4*)(xout + ro + 512 * j + 4) = (f32x4){v[j * 8 + 4], v[j * 8 + 5], v[j * 8 + 6], v[j * 8 + 7]}; }
                else *(u32x4*)(XBp + ro + 512 * j) = pack8(&v[j * 8]); } }
    }
}

__device__ __forceinline__ void p_front1(const Args& a, int vcu, int G, int WV_) {
    const int tid = otid(), lane = tid & 63, wave = tid >> 6, gw = vcu * NWAVES + wave, NGW = G * NWAVES;
    const bf16_t* Z = (const bf16_t*)(KWS(a) + WS_Z); bf16_t* MK = (bf16_t*)(KWS(a) + WS_MK); const float* TAB = (const float*)(KWS(a) + WS_TAB);
    for (int g = gw; g * 32 < NTOK; g += NGW) { const int row = g * 32 + (lane >> 1), i8 = lane & 1, pos = row & (SEQ - 1);
        const bf16_t* p1 = Z + (size_t)row * LDZ1 + Z1_KR + i8 * 8;
        u32x4 w1 = *(const u32x4*)p1, w2 = *(const u32x4*)(p1 + 16);
        rot8(w1, w2, TAB + TAB_COSM + (size_t)pos * 16 + i8 * 8, TAB + TAB_SINM + (size_t)pos * 16 + i8 * 8, 1.f);
        u32x4 lo, hi2;
        lo.x = (w1.x & 0xffffu) | (w2.x << 16); lo.y = (w1.x >> 16) | (w2.x & 0xffff0000u); lo.z = (w1.y & 0xffffu) | (w2.y << 16); lo.w = (w1.y >> 16) | (w2.y & 0xffff0000u);
        hi2.x = (w1.z & 0xffffu) | (w2.z << 16); hi2.y = (w1.z >> 16) | (w2.z & 0xffff0000u); hi2.z = (w1.w & 0xffffu) | (w2.w << 16); hi2.w = (w1.w >> 16) | (w2.w & 0xffff0000u);
#pragma unroll
        for (int h = 0; h < 4; ++h) { bf16_t* d = MK + (size_t)row * 512 + h * 128 + 64 + 16 * i8; *(u32x4*)d = lo; *(u32x4*)(d + 8) = hi2; } }
    float* BF = (float*)(KWS(a) + WS_BF); float* BB = (float*)(KWS(a) + WS_BB);
    const int dir = tid >> 8, j = tid & 255;
    const float* w2p = dir ? KARG(a, 17) : KARG(a, 15); const float bias = (dir ? KARG(a, 18) : KARG(a, 16))[j];
    float wv[16];
#pragma unroll
    for (int i = 0; i < 16; ++i) wv[i] = w2p[i * 256 + j];
    float* Bo = dir ? BB : BF;
    const bool split = (G == 256); const int u0 = split ? (int)blockIdx.x - 128 : vcu, ustep = split ? 128 : G;
    for (int u = u0; u >= 0 && u < 256; u += ustep) { const long rb = (long)(u >> 7) * SEQ + (long)(u & 127) * 64; float run = 0.f;
        for (int s0 = 0; s0 < 64; s0 += 8) { u32x4 l0[8], l1[8];
#pragma unroll
            for (int i = 0; i < 8; ++i) { const long row = rb + (dir ? 63 - (s0 + i) : (s0 + i)); l0[i] = *(const u32x4*)(Z + (size_t)row * LDZ1 + Z1_LRF + dir * 16); l1[i] = *(const u32x4*)(Z + (size_t)row * LDZ1 + Z1_LRF + dir * 16 + 8); }
#pragma unroll
            for (int i = 0; i < 8; ++i) { const long row = rb + (dir ? 63 - (s0 + i) : (s0 + i));
                float z = bias;
                z += bflo(l0[i].x) * wv[0] + bfhi(l0[i].x) * wv[1] + bflo(l0[i].y) * wv[2] + bfhi(l0[i].y) * wv[3] + bflo(l0[i].z) * wv[4] + bfhi(l0[i].z) * wv[5] + bflo(l0[i].w) * wv[6] + bfhi(l0[i].w) * wv[7];
                z += bflo(l1[i].x) * wv[8] + bfhi(l1[i].x) * wv[9] + bflo(l1[i].y) * wv[10] + bfhi(l1[i].y) * wv[11] + bflo(l1[i].z) * wv[12] + bfhi(l1[i].z) * wv[13] + bflo(l1[i].w) * wv[14] + bfhi(l1[i].w) * wv[15];
                const float ls = fminf(z, 0.f) - __logf(1.f + __expf(-fabsf(z)));
                run += ls * (1.f / 16.f);
                Bo[(size_t)row * 256 + j] = run; } } }
}

constexpr int NPHASE = 28;
__global__ void __launch_bounds__(NWAVES * 64, 2) mega_fwd(Args args) {
    extern __shared__ __attribute__((aligned(16))) unsigned char lds_raw[];
    char* lds = (char*)lds_raw; LAS unsigned char* ldsl = (LAS unsigned char*)lds_raw;
    const int WV_ = __builtin_amdgcn_readfirstlane((int)threadIdx.x >> 6);
    const int tid = otid();
    const int G = gridDim.x; const int bx = blockIdx.x; const int vcu = (G % 8 == 0) ? (bx % 8) * (G / 8) + bx / 8 : bx;
    volatile LAS unsigned* MISC = (volatile LAS unsigned*)(ldsl + MISC_OFF);
    for (int u = tid; u < (LDS_BYTES - RING_BYTES) / 4; u += NWAVES * 64) ((LAS unsigned*)(ldsl + RING_BYTES))[u] = 0u;
    __syncthreads();
#define ws KWS(args)
    unsigned* ctl = (unsigned*)(ws + WS_CTL);
    const int lo = args.ph_lo, hi = args.ph_hi;
    const bool use_bar = (hi - lo) > 1;
    XcdBarrier bar; bar.bar = ctl + CW_BAR; bar.x = 0; bar.st = nullptr;
    if (use_bar) bar = xcd_barrier_post(ctl + CW_BAR, MISC + 8, WV_);
#define IN(k) (lo <= (k) && (k) < hi)
#define SEAM(k) do { if (IN(k) && IN((k) + 1)) xcd_barrier(bar, WV_); } while (0)
#define XB ((bf16_t*)(ws + WS_XB))
#define ZBUF ((bf16_t*)(ws + WS_Z))
#define A2 ((bf16_t*)(ws + WS_A2))
#define X1F ((float*)(ws + WS_X1F))
#define Y ((float*)(ws + WS_Y))

    if (IN(0)) { p_prologue(args, lds, vcu, G, WV_); } SEAM(0);
    if (IN(1)) { pg8::Gemm g{XB, (const bf16_t*)(ws + WS_WIN0), 1024, 1024, 1024}; pg8::StaticOrder S; S.init(NTOK, LDZ0, G, bx);
        pg8::EpiBf16 E{ZBUF, LDZ0, 0, 0}; pg8::gemm_phase<pg8::EpiBf16, pg8::StaticOrder, true>(ldsl, g, S, E, WV_); } SEAM(1);
    if (IN(2)) { p_rot0(args, vcu, G, WV_); } SEAM(2);
    {
        chk::Cfg cf; cf.Z = ZBUF; cf.ld = LDZ0; cf.qcol = Z0_RQ; cf.kcol = Z0_RK; cf.vcol = Z0_RV; cf.gcol = Z0_RG; cf.BF = nullptr; cf.BB = nullptr;
        cf.dec_f = KARG(args, 2); cf.dec_b = KARG(args, 3); cf.qscale = 1.f; cf.U = (bf16_t*)(ws + WS_U); cf.OUT = A2; cf.ldo = 1024; cf.ocol = 0; cf.gain = nullptr;
        if (IN(3)) { for (int u = vcu; u < 256; u += G) chk::chunk_states<128, true>(cf, lds, u, WV_); } SEAM(3);
        if (IN(4)) { chk::chunk_scan<128, true>(cf, bx * 512 + tid); } SEAM(4);
        if (IN(5)) { for (int u = vcu; u < 256; u += G) chk::chunk_out<128, true>(cf, lds, u, WV_); } SEAM(5);
    }
    if (IN(6)) { float* OAB = (float*)(ws + WS_OAB);
        const int ln = tid & 63; float s1 = KARG(args, 4)[ln] * KARG(args, 5)[ln], s2 = KARG(args, 6)[ln] * KARG(args, 7)[ln]; s1 = wave_sum(s1); s2 = wave_sum(s2);
        const float lam = (expf(s1) - expf(s2)) + 0.2f;
        for (int u = vcu; u < 256; u += G) { const int bh = u >> 5, qb = u & 31, h = bh & 3, b = bh >> 2;
            const size_t r0 = (size_t)b * SEQ; const bf16_t* Qp = ZBUF + (r0 + qb * 256) * LDZ0 + Z0_DQ + h * 128; const bf16_t* Kp = ZBUF + r0 * LDZ0 + Z0_DK + h * 128; const bf16_t* Vp = ZBUF + r0 * LDZ0 + Z0_DV + h * 128;
            float* Op = OAB + (r0 + qb * 256) * 512 + h * 128;
            att::attn_dense_body<0, 4, float>(Qp, LDZ0, Kp, LDZ0, Vp, LDZ0, Op, 512, SEQ, 0.125f, lds, WV_);
            att::attn_dense_body<4, 8, bf16_t, true>(Qp, LDZ0, Kp, LDZ0, Vp, LDZ0, A2 + (r0 + qb * 256) * 1024 + 512 + h * 128, 1024, SEQ, 0.125f, lds, WV_, Op, 512, lam, KARG(args, 8)); } } SEAM(6);
    if (IN(8)) { pg8::Gemm g{A2, (const bf16_t*)(ws + WS_WOUT0), 1024, 1024, 1024}; pg8::StaticOrder S; S.init(NTOK, 1024, G, bx);
        pg8::EpiBf16 E{(bf16_t*)Y, 1024, 0, 0}; pg8::gemm_phase<pg8::EpiBf16, pg8::StaticOrder, true>(ldsl, g, S, E, WV_); } SEAM(8);
    if (IN(9)) { p_ln1_router<false>(args, lds, vcu, G, 0, XB, WV_); } SEAM(9);
    if (IN(10)) { p_moe_scatter(args, lds, vcu, G, 0, WV_); } SEAM(10);
    if (IN(11)) { pg8::Gemm g{XB, (const bf16_t*)(ws + WS_WGU), 1024, 1024, 1024}; pg8::MoeOrder S{(const int*)(ws + WS_TILES), G, vcu, 1024};
        pg8::EpiGU E{(bf16_t*)(ws + WS_H), 512}; pg8::gemm_phase<pg8::EpiGU, pg8::MoeOrder, true, true>(ldsl, g, S, E, WV_, (const int2*)(ws + WS_ROWINFO)); } SEAM(11);
    if (IN(12)) { pg8::Gemm g{(const bf16_t*)(ws + WS_H), (const bf16_t*)(ws + WS_WDN), 512, 512, 512}; pg8::MoeOrder S{(const int*)(ws + WS_TILES), G, vcu, 1024};
        pg8::EpiDown E{(bf16_t*)(ws + WS_YS), (const int2*)(ws + WS_ROWINFO)}; pg8::gemm_phase<pg8::EpiDown, pg8::MoeOrder, true>(ldsl, g, S, E, WV_); } SEAM(12);
    if (IN(13)) { p_ln2<false>(args, vcu, G, 0, nullptr, WV_);
        { const int lane = tid & 63, wave = tid >> 6; LAS float* scr = (LAS float*)((LAS char*)lds + wave * 16384);
          for (int it = vcu * NWAVES + wave; it < 32 * 768; it += G * NWAVES) moe_weight_item(args, 1, it, scr, lane); } } SEAM(13);
    if (IN(14)) { pg8::Gemm g{XB, (const bf16_t*)(ws + WS_WIN1), 1024, 1024, 1024}; pg8::StaticOrder S; S.init(NTOK, LDZ1, G, bx);
        pg8::EpiBf16 E{ZBUF, LDZ1, 0, 0}; pg8::gemm_phase<pg8::EpiBf16, pg8::StaticOrder, true>(ldsl, g, S, E, WV_); } SEAM(14);
    if (IN(15)) { p_front1(args, vcu, G, WV_);
        const float* TABp = (const float*)(ws + WS_TAB);
        { pg8::Gemm g{ZBUF + Z1_CQ, (const bf16_t*)(ws + WS_WUQ), LDZ1, 256, 256}; pg8::StaticOrder S; S.init(NTOK, 512, G, bx);
          pg8::EpiNormUp<0, true, false> E{(bf16_t*)(ws + WS_MQ), 512, 0, 0, nullptr, 0, TABp + TAB_COSM, TABp + TAB_SINM}; pg8::gemm_phase<pg8::EpiNormUp<0, true, false>, pg8::StaticOrder, true>(ldsl, g, S, E, WV_); }
        { pg8::Gemm g{ZBUF + Z1_CKV, (const bf16_t*)(ws + WS_WUKV), LDZ1, 256, 256}; pg8::StaticOrder S; S.init(NTOK, 1024, G, bx);
          pg8::EpiNormUp<128, false, true> E{(bf16_t*)(ws + WS_MK), 512, 512, (size_t)(WS_MV - WS_MK) / 2, ZBUF + Z1_CKV, LDZ1, nullptr, nullptr}; pg8::gemm_phase<pg8::EpiNormUp<128, false, true>, pg8::StaticOrder, true>(ldsl, g, S, E, WV_); }
    } SEAM(15);
    if (IN(18)) { const bf16_t* MQ = (const bf16_t*)(ws + WS_MQ); const bf16_t* MK = (const bf16_t*)(ws + WS_MK); const bf16_t* MV = (const bf16_t*)(ws + WS_MV);
        for (int u = vcu; u < 256; u += G) { const int bh = u >> 5, qb = u & 31, h = bh & 3, b = bh >> 2; const size_t r0 = (size_t)b * SEQ;
            att::attn_dense_body<0, 6, bf16_t>(MQ + (r0 + qb * 256) * 512 + h * 128, 512, MK + r0 * 512 + h * 128, 512, MV + r0 * 512 + h * 128, 512,
                                               A2 + (r0 + qb * 256) * 1024 + h * 128, 1024, SEQ, 0.10206207261596577f, lds, WV_, nullptr, 0, 0.f, nullptr, ZBUF + (r0 + qb * 256) * LDZ1 + Z1_CQ, LDZ1); } } SEAM(18);
    {
        chk::Cfg cf; cf.Z = ZBUF; cf.ld = LDZ1; cf.qcol = Z1_GQ; cf.kcol = Z1_GK; cf.vcol = Z1_GV; cf.gcol = Z1_GG; cf.BF = (const float*)(ws + WS_BF); cf.BB = (const float*)(ws + WS_BB);
        cf.dec_f = nullptr; cf.dec_b = nullptr; cf.qscale = 0.125f; cf.U = (bf16_t*)(ws + WS_U); cf.OUT = A2; cf.ldo = 1024; cf.ocol = 512; cf.gain = KARG(args, 19);
        if (IN(19)) { for (int u = vcu; u < 256; u += G) chk::chunk_states<64, false>(cf, lds, u, WV_); } SEAM(19);
        if (IN(20)) { if (tid < 256) chk::chunk_scan<64, false>(cf, bx * 256 + tid); } SEAM(20);
        if (IN(21)) { for (int u = vcu; u < 256; u += G) chk::chunk_out<64, false>(cf, lds, u, WV_); } SEAM(21);
    }
    if (IN(22)) { pg8::Gemm g{A2, (const bf16_t*)(ws + WS_WOUT1), 1024, 1024, 1024}; pg8::StaticOrder S; S.init(NTOK, 1024, G, bx);
        pg8::EpiBf16 E{(bf16_t*)Y, 1024, 0, 0}; pg8::gemm_phase<pg8::EpiBf16, pg8::StaticOrder, true>(ldsl, g, S, E, WV_); } SEAM(22);
    if (IN(23)) { p_ln1_router<false>(args, lds, vcu, G, 1, XB, WV_); } SEAM(23);
    if (IN(24)) { p_moe_scatter(args, lds, vcu, G, 1, WV_); } SEAM(24);
    if (IN(25)) { pg8::Gemm g{XB, (const bf16_t*)(ws + WS_WGU), 1024, 1024, 1024}; pg8::MoeOrder S{(const int*)(ws + WS_TILES), G, vcu, 1024};
        pg8::EpiGU E{(bf16_t*)(ws + WS_H), 512}; pg8::gemm_phase<pg8::EpiGU, pg8::MoeOrder, true, true>(ldsl, g, S, E, WV_, (const int2*)(ws + WS_ROWINFO)); } SEAM(25);
    if (IN(26)) { pg8::Gemm g{(const bf16_t*)(ws + WS_H), (const bf16_t*)(ws + WS_WDN), 512, 512, 512}; pg8::MoeOrder S{(const int*)(ws + WS_TILES), G, vcu, 1024};
        pg8::EpiDown E{(bf16_t*)(ws + WS_YS), (const int2*)(ws + WS_ROWINFO)}; pg8::gemm_phase<pg8::EpiDown, pg8::MoeOrder, true>(ldsl, g, S, E, WV_); } SEAM(26);
    if (IN(27)) { p_ln2<true>(args, vcu, G, 1, KOUT(args), WV_); }
#undef IN
#undef SEAM
#undef ws
#undef XB
#undef ZBUF
#undef A2
#undef X1F
#undef Y
}

#ifndef DBG_STOP
#define DBG_STOP -1
#endif
__global__ void dbg_dump(const void* src, int is_bf16, float* out, size_t n, int sanitize_only) {
    for (size_t i = (size_t)blockIdx.x * blockDim.x + threadIdx.x; i < n; i += (size_t)gridDim.x * blockDim.x) {
        float v = (sanitize_only == 1) ? out[i] : (is_bf16 ? bf1(((const bf16_t*)src)[i]) : ((const float*)src)[i]);
        if (!(fabsf(v) < 1e30f)) v = 777.f;
        if (sanitize_only == 2 && (i & 1023) >= 512) v = 0.f;
        if (sanitize_only == 3 && (i & 1023) < 512) v = 0.f;
        out[i] = v; }
}
#ifndef MK_SPLIT
#define MK_SPLIT 0
#endif
extern "C" void kernel_launch(void* const* d_in, const int* in_sizes, int n_in, void* d_out, int out_size, void* d_ws, size_t ws_size, hipStream_t stream) {
    static int grid = 0;
    if (grid == 0) {
        if (n_in != 32 || out_size != NTOK * DM || ws_size < WS_END) { fprintf(stderr, "kernel_launch: unexpected shapes (n_in %d, out %d, ws %zu < %zu)\n", n_in, out_size, ws_size, (size_t)WS_END); grid = -1; return; }
        int dev = 0, cus = 0, per_cu = 0;
        if (hipGetDevice(&dev) != hipSuccess || hipDeviceGetAttribute(&cus, hipDeviceAttributeMultiprocessorCount, dev) != hipSuccess) { grid = -1; return; }
        if (hipFuncSetAttribute((const void*)mega_fwd, hipFuncAttributeMaxDynamicSharedMemorySize, LDS_BYTES) != hipSuccess) { fprintf(stderr, "kernel_launch: hipFuncSetAttribute failed\n"); grid = -1; return; }
        if (hipOccupancyMaxActiveBlocksPerMultiprocessor(&per_cu, (const void*)mega_fwd, NWAVES * 64, LDS_BYTES) != hipSuccess || per_cu < 1)
            fprintf(stderr, "kernel_launch: occupancy query reports %d\n", per_cu);
        (void)hipGetLastError();
        grid = cus;
    }
    if (grid < 0) return;
    (void)hipMemsetAsync((char*)d_ws + WS_CTL, 0, CTL_ZERO_BYTES, stream);
    Args a{};
    for (int i = 0; i < 32; ++i) a.in[i] = (const float*)d_in[i];
    a.out = (float*)d_out; a.ws = (unsigned char*)d_ws;
#if MK_SPLIT
    const int plast = (DBG_STOP >= 0) ? DBG_STOP : NPHASE - 1;
    for (int p = 0; p <= plast; ++p) { a.ph_lo = p; a.ph_hi = p + 1; hipLaunchKernelGGL(mega_fwd, dim3(grid), dim3(NWAVES * 64), LDS_BYTES, stream, a); }
    if (DBG_STOP >= 0) {
        const void* srcp = nullptr; int isb = 0, sano = 0;
        switch (DBG_STOP) {
            case 1: case 2: srcp = (char*)d_ws + WS_Z; isb = 1; break;
            case 5: case 18: srcp = (char*)d_ws + WS_A2; isb = 1; sano = 2; break;
            case 7: case 21: srcp = (char*)d_ws + WS_A2; isb = 1; sano = 3; break;
            case 3: case 4: case 19: case 20: srcp = (char*)d_ws + WS_U; isb = 1; break;
            case 6: srcp = (char*)d_ws + WS_OAB; isb = 0; break;
            case 8: case 22: srcp = (char*)d_ws + WS_Y; isb = 0; break;
            case 9: case 23: srcp = (char*)d_ws + WS_X1F; isb = 0; break;
            case 12: case 26: srcp = (char*)d_ws + WS_YS; isb = 1; break;
            case 14: case 16: srcp = (char*)d_ws + WS_Z; isb = 1; break;
            default: sano = 1; break;
        }
        hipLaunchKernelGGL(dbg_dump, dim3(2048), dim3(256), 0, stream, srcp, isb, (float*)d_out, (size_t)NTOK * DM, sano);
    }
#else
#ifdef PROBE_REP
    a.ph_lo = 0; a.ph_hi = PROBE_REP_HI; hipLaunchKernelGGL(mega_fwd, dim3(grid), dim3(NWAVES * 64), LDS_BYTES, stream, a);
    if (PROBE_REP == 9 || PROBE_REP == 23) (void)hipMemsetAsync((char*)d_ws + WS_CTL + CW_CNT0 * 4, 0, 512, stream);
    for (int r = 0; r < PROBE_REP_N; ++r) for (int p = PROBE_REP; p < PROBE_REP_HI; ++p) { a.ph_lo = p; a.ph_hi = p + 1; hipLaunchKernelGGL(mega_fwd, dim3(grid), dim3(NWAVES * 64), LDS_BYTES, stream, a); }
    if (PROBE_REP_HI < NPHASE) { (void)hipMemsetAsync((char*)d_ws + WS_CTL + CW_BAR * 4, 0, XCD_BAR_WORDS * 4, stream); a.ph_lo = PROBE_REP_HI; a.ph_hi = NPHASE; hipLaunchKernelGGL(mega_fwd, dim3(grid), dim3(NWAVES * 64), LDS_BYTES, stream, a); }
#else
    a.ph_lo = 0; a.ph_hi = NPHASE; hipLaunchKernelGGL(mega_fwd, dim3(grid), dim3(NWAVES * 64), LDS_BYTES, stream, a);
#endif
#endif
}
```

```cpp
#include <hip/hip_runtime.h>
#include <cstdio>
#include <cstdint>

#define LAS __attribute__((address_space(3)))
typedef unsigned short bf16_t;
typedef short bf16x8 __attribute__((ext_vector_type(8)));
typedef short s16x4 __attribute__((ext_vector_type(4)));
typedef short v4i16_t __attribute__((ext_vector_type(4)));
typedef float f32x2 __attribute__((ext_vector_type(2)));
typedef float f32x4 __attribute__((ext_vector_type(4)));
typedef float f32x16 __attribute__((ext_vector_type(16)));
typedef unsigned u32x2 __attribute__((ext_vector_type(2)));
typedef int i32x2 __attribute__((ext_vector_type(2)));
typedef unsigned u32x4 __attribute__((ext_vector_type(4)));

constexpr int NTOK = 16384, SEQ = 8192, DM = 1024, NCHUNK = 128;
constexpr int LDZ0 = 3584, LDZ1 = 2048;
constexpr int Z0_RQ = 0, Z0_RK = 512, Z0_RV = 1024, Z0_RG = 1536, Z0_DQ = 2048, Z0_DK = 2560, Z0_DV = 3072;
constexpr int Z1_CQ = 0, Z1_CKV = 256, Z1_KR = 384, Z1_GQ = 416, Z1_GK = 672, Z1_GV = 928, Z1_GG = 1440, Z1_LRF = 1952, Z1_LRB = 1968;
constexpr float ALPHA = 1.4142135623730951f;
constexpr float LN_EPS = 1e-5f;
constexpr int MOE_CAP = 32768 + 32 * 256;
constexpr int MAX_TILES = MOE_CAP / 256;

constexpr size_t MiB = 1u << 20;
constexpr size_t WS_CTL = 0, CTL_ZERO_BYTES = 64 * 1024;
constexpr size_t WS_TAB = 1 * MiB;
constexpr size_t WS_WR = 7 * MiB;
constexpr size_t WS_WUQ = 7 * MiB + 512 * 1024;
constexpr size_t WS_WUKV = 8 * MiB;
constexpr size_t WS_WIN0 = 9 * MiB;
constexpr size_t WS_WOUT0 = 16 * MiB;
constexpr size_t WS_WIN1 = 18 * MiB;
constexpr size_t WS_WOUT1 = 22 * MiB;
constexpr size_t WS_WGU = 24 * MiB;
constexpr size_t WS_WDN = 88 * MiB;
constexpr size_t WS_X1F = 120 * MiB;
constexpr size_t WS_XB = 184 * MiB;
constexpr size_t WS_A2 = 216 * MiB;
constexpr size_t WS_ASG = 248 * MiB;
constexpr size_t WS_ROWINFO = 249 * MiB;
constexpr size_t WS_TILES = 250 * MiB;
constexpr size_t WS_CNTB = 251 * MiB;
constexpr size_t WS_S = 252 * MiB;
constexpr size_t WS_Z = WS_S;
constexpr size_t WS_U = WS_S + 112 * MiB;
constexpr size_t WS_OAB = WS_S + 176 * MiB;
constexpr size_t WS_MQ = WS_S + 64 * MiB;
constexpr size_t WS_MK = WS_S + 80 * MiB;
constexpr size_t WS_MV = WS_S + 96 * MiB;
constexpr size_t WS_AQ = WS_S + 176 * MiB;
constexpr size_t WS_AKV = WS_S + 184 * MiB;
constexpr size_t WS_BF = WS_S + 192 * MiB;
constexpr size_t WS_BB = WS_S + 208 * MiB;
constexpr size_t WS_Y = WS_S;
constexpr size_t WS_XS = WS_S + 64 * MiB;
constexpr size_t WS_H = WS_S + 144 * MiB;
constexpr size_t WS_YS = WS_S + 184 * MiB;
constexpr size_t WS_END = WS_S + 256 * MiB;
constexpr size_t TAB_COSR = 0, TAB_SINR = 8192 * 64, TAB_COSD = 2 * 8192 * 64, TAB_SIND = TAB_COSD + 8192 * 8, TAB_COSM = TAB_SIND + 8192 * 8, TAB_SINM = TAB_COSM + 8192 * 16;
constexpr int CW_BAR = 1024;
constexpr int CW_CNT0 = 8192, CW_CNT1 = 8192 + 64;

typedef __bf16 bf16x2_t __attribute__((ext_vector_type(2)));
__device__ __forceinline__ unsigned cvtpk_asm(float lo, float hi) { unsigned r; asm volatile("v_cvt_pk_bf16_f32 %0, %1, %2" : "=v"(r) : "v"(lo), "v"(hi)); return r; }
__device__ __forceinline__ unsigned cvtpk(float lo, float hi) { f32x2 v = {lo, hi}; bf16x2_t b = __builtin_convertvector(v, bf16x2_t); return __builtin_bit_cast(unsigned, b); }
__device__ __forceinline__ float bflo(unsigned w) { return __uint_as_float(w << 16); }
__device__ __forceinline__ float bfhi(unsigned w) { return __uint_as_float(w & 0xffff0000u); }
__device__ __forceinline__ float bf1(bf16_t b) { return __uint_as_float(((unsigned)b) << 16); }
__device__ __forceinline__ bf16_t f2bf(float f) { return (bf16_t)(cvtpk(f, 0.f) & 0xffffu); }
__device__ __forceinline__ float wave_sum(float v) {
#pragma unroll
    for (int o = 1; o < 64; o <<= 1) v += __shfl_xor(v, o);
    return v;
}
__device__ __forceinline__ float half_sum(float v) {
#pragma unroll
    for (int o = 1; o < 32; o <<= 1) v += __shfl_xor(v, o);
    return v;
}
__device__ __forceinline__ float silu_f(float x) { return x * __builtin_amdgcn_rcpf(1.f + __expf(-x)); }
__device__ __forceinline__ int otid_(int wv) { unsigned l; asm volatile("v_mbcnt_lo_u32_b32 %0, -1, 0\n\tv_mbcnt_hi_u32_b32 %0, -1, %0" : "=v"(l)); return (wv << 6) | (int)l; }
#define otid() otid_(WV_)
#define LDS_WAIT() asm volatile("s_waitcnt lgkmcnt(0)" ::: "memory")
#define VM_WAIT() asm volatile("s_waitcnt vmcnt(0)" ::: "memory")

namespace pg8 {
constexpr int BM = 256, BK = 64, HALF = 128, HTB = HALF * BK * 2, STAGE_BYTES = 8 * HTB, NXCD = 8, WGM = 8;
__host__ __device__ __forceinline__ int lds_byte(int r, int c) { const int st = (r >> 4) * 2 + (c >> 5), rr = r & 15, cc = c & 31, ob = rr * 64 + cc * 2; return st * 1024 + (ob ^ (((ob >> 9) & 1) << 5)); }
__host__ __device__ __forceinline__ void stage_rc(int b, int& R, int& C) { const int st = b / 1024, sb = b % 1024, swz = sb ^ (((sb >> 9) & 1) << 5); R = (st >> 1) * 16 + swz / 64; C = (st & 1) * 32 + (swz % 64) / 2; }
__host__ __device__ __forceinline__ int perm32(int rho) { const int n = rho >> 4, i = rho & 15; return 8 * (i >> 2) + 4 * n + (i & 3); }

struct Unit { int pm, pn, brow; };
struct Gemm { const bf16_t* A; const bf16_t* Bt; int lda, ldb, K; };

struct StaticOrder {
    int nM, nN, nwg, G, c;
    __device__ void init(int M, int N, int G_, int c_) { nM = M / BM; nN = N / BM; nwg = nM * nN; G = G_; c = c_; }
    __device__ bool next(int i, Unit& u) const {
        const long L = (long)i * G + c; if (L >= nwg) return false;
        int wgid = (int)L; { const int q = nwg / NXCD, r = nwg % NXCD, xcd = wgid % NXCD, off = wgid / NXCD; wgid = (xcd < r ? xcd * (q + 1) : r * (q + 1) + (xcd - r) * q) + off; }
        const int nig = WGM * nN, gid = wgid / nig, fm = gid * WGM, gsz = (nM - fm) < WGM ? (nM - fm) : WGM;
        u.pm = fm + ((wgid % nig) % gsz); u.pn = (wgid % nig) / gsz; u.brow = u.pn * BM; return true;
    }
};
struct MoeOrder {
    const int* tiles; int G, c, rows_per_expert;
    __device__ bool next(int i, Unit& u) const {
        const int nt = tiles[0]; const int L = i * G + c; if (L >= nt * 4) return false;
        const int t = L >> 2; u.pm = t; u.pn = L & 3; u.brow = tiles[1 + t] * rows_per_expert + u.pn * BM; return true;
    }
};

struct EpiF32 {
    static constexpr bool PERM = false;
    float* C; int ldc;
    __device__ __forceinline__ void operator()(const f32x4 (&acc)[2][2][4][2], const Unit& u, int wr, int wc, int fr, int fq) const {
        const int row0 = u.pm * BM + wr * 64 + fr, col0 = u.pn * BM + wc * 32 + 4 * fq;
#pragma unroll
        for (int ai = 0; ai < 2; ++ai)
#pragma unroll
            for (int m = 0; m < 4; ++m) { float* rowp = C + (size_t)(row0 + ai * HALF + m * 16) * ldc + col0;
#pragma unroll
                for (int bj = 0; bj < 2; ++bj)
#pragma unroll
                    for (int n = 0; n < 2; ++n) *(f32x4*)(rowp + bj * HALF + n * 16) = acc[ai][bj][m][n]; }
    }
};
struct EpiBf16 {
    static constexpr bool PERM = true;
    bf16_t* O; int ldc; int split_cols; size_t split_stride;
    __device__ __forceinline__ void operator()(const f32x4 (&acc)[2][2][4][2], const Unit& u, int wr, int wc, int fr, int fq) const {
        const int row0 = u.pm * BM + wr * 64 + fr; int colt = u.pn * BM; bf16_t* base = O;
        if (split_cols) { const int t = colt / split_cols; base += (size_t)t * split_stride; colt -= t * split_cols; }
        const int col0 = colt + wc * 32 + 8 * fq;
#pragma unroll
        for (int ai = 0; ai < 2; ++ai)
#pragma unroll
            for (int m = 0; m < 4; ++m) { bf16_t* rowp = base + (size_t)(row0 + ai * HALF + m * 16) * ldc + col0;
#pragma unroll
                for (int bj = 0; bj < 2; ++bj) { const f32x4 v0 = acc[ai][bj][m][0], v1 = acc[ai][bj][m][1];
                    u32x4 w; w.x = cvtpk(v0[0], v0[1]); w.y = cvtpk(v0[2], v0[3]); w.z = cvtpk(v1[0], v1[1]); w.w = cvtpk(v1[2], v1[3]);
                    *(u32x4*)(rowp + bj * HALF) = w; } }
    }
};
struct EpiGU {
    static constexpr bool PERM = true;
    bf16_t* H; int ldh;
    __device__ __forceinline__ void operator()(const f32x4 (&acc)[2][2][4][2], const Unit& u, int wr, int wc, int fr, int fq) const {
        const int row0 = u.pm * BM + wr * 64 + fr, col0 = u.pn * HALF + wc * 32 + 8 * fq;
#pragma unroll
        for (int ai = 0; ai < 2; ++ai)
#pragma unroll
            for (int m = 0; m < 4; ++m) { bf16_t* rowp = H + (size_t)(row0 + ai * HALF + m * 16) * ldh + col0;
                float h[8];
#pragma unroll
                for (int n = 0; n < 2; ++n)
#pragma unroll
                    for (int j = 0; j < 4; ++j) h[n * 4 + j] = silu_f(acc[ai][0][m][n][j]) * acc[ai][1][m][n][j];
                u32x4 w; w.x = cvtpk(h[0], h[1]); w.y = cvtpk(h[2], h[3]); w.z = cvtpk(h[4], h[5]); w.w = cvtpk(h[6], h[7]);
                *(u32x4*)rowp = w; }
    }
};
struct EpiDown {
    static constexpr bool PERM = true; static constexpr bool ROWINFO_LDS = true;
    bf16_t* YS; const int2* rowinfo;
    __device__ __forceinline__ void operator()(const f32x4 (&acc)[2][2][4][2], const Unit& u, int wr, int wc, int fr, int fq, const LAS i32x2* ril) const {
        const int lrow0 = wr * 64 + fr, col0 = u.pn * BM + wc * 32 + 8 * fq;
#pragma unroll
        for (int ai = 0; ai < 2; ++ai)
#pragma unroll
            for (int m = 0; m < 4; ++m) { const i32x2 ri = ril[lrow0 + ai * HALF + m * 16];
                if (ri.x >= 0) { const float g = __int_as_float(ri.y); const int tok = ri.x >> 1, k = ri.x & 1;
                    bf16_t* rowp = YS + ((size_t)k * NTOK + tok) * DM + col0;
#pragma unroll
                    for (int bj = 0; bj < 2; ++bj) { const f32x4 v0 = acc[ai][bj][m][0] * g, v1 = acc[ai][bj][m][1] * g;
                        u32x4 w; w.x = cvtpk(v0[0], v0[1]); w.y = cvtpk(v0[2], v0[3]); w.z = cvtpk(v1[0], v1[1]); w.w = cvtpk(v1[2], v1[3]);
                        *(u32x4*)(rowp + bj * HALF) = w; } } }
    }
};

template <int NRMS, bool ROPE, bool KSKIP> struct EpiNormUp {
    static constexpr bool PERM = true;
    bf16_t* O; int ldc; int split_cols; size_t split_stride; const bf16_t* Zs; int ldz; const float* cosT; const float* sinT;
    __device__ __forceinline__ void operator()(const f32x4 (&acc)[2][2][4][2], const Unit& u, int wr, int wc, int fr_, int fq_) const {
        int fr = fr_, fq = fq_; asm volatile("" : "+v"(fr), "+v"(fq));
        const int row0 = u.pm * BM + wr * 64 + fr; int colt = u.pn * BM; bf16_t* base = O; bool kpart = false;
        if (split_cols) { const int t = colt / split_cols; base += (size_t)t * split_stride; colt -= t * split_cols; kpart = (t == 0); }
        if (KSKIP && kpart && wc >= 2) return;
        const int col0 = colt + wc * 32 + 8 * fq;
        constexpr int NL = NRMS > 0 ? NRMS / 32 : 1;
#pragma unroll
        for (int ai = 0; ai < 2; ++ai) {
            float rstd[4] = {1.f, 1.f, 1.f, 1.f};
            constexpr int RB = (NRMS > 128) ? 1 : 2;
            if constexpr (NRMS > 0) {
#pragma unroll
            for (int mp = 0; mp < 4; mp += RB) {
                u32x4 zw[RB][NL];
#pragma unroll
                for (int m2 = 0; m2 < RB; ++m2)
#pragma unroll
                    for (int q = 0; q < NL; ++q) zw[m2][q] = *(const u32x4*)(Zs + (size_t)(row0 + ai * HALF + (mp + m2) * 16) * ldz + fq * (NRMS / 4) + q * 8);
#pragma unroll
                for (int m2 = 0; m2 < RB; ++m2) { float ss = 0.f;
#pragma unroll
                    for (int q = 0; q < NL; ++q) { const u32x4 w = zw[m2][q]; const float a0 = bflo(w.x), a1 = bfhi(w.x), a2 = bflo(w.y), a3 = bfhi(w.y), a4 = bflo(w.z), a5 = bfhi(w.z), a6 = bflo(w.w), a7 = bfhi(w.w);
                        ss += (a0 * a0 + a1 * a1) + (a2 * a2 + a3 * a3) + (a4 * a4 + a5 * a5) + (a6 * a6 + a7 * a7); }
                    ss += __shfl_xor(ss, 16); ss += __shfl_xor(ss, 32);
                    rstd[mp + m2] = 1.f / sqrtf(ss * (1.f / (NRMS > 0 ? NRMS : 1)) + 1e-6f); }
                __builtin_amdgcn_sched_barrier(0);
            } }
#pragma unroll
            for (int m = 0; m < 4; ++m) { const int row = row0 + ai * HALF + m * 16; bf16_t* rowp = base + (size_t)row * ldc + col0;
                f32x4 cs = {1.f, 1.f, 1.f, 1.f}, sn = {0.f, 0.f, 0.f, 0.f};
                if (ROPE && wc == 2) { const int pos = row & (SEQ - 1); cs = *(const f32x4*)(cosT + (size_t)pos * 16 + 4 * fq); sn = *(const f32x4*)(sinT + (size_t)pos * 16 + 4 * fq); }
#pragma unroll
                for (int bj = 0; bj < 2; ++bj) { f32x4 v0 = acc[ai][bj][m][0] * rstd[m], v1 = acc[ai][bj][m][1] * rstd[m];
                    if (ROPE && wc == 2) {
                        const f32x4 a = v0, b = v1;
                        v0[0] = a[0] * cs[0] - a[1] * sn[0]; v0[1] = a[1] * cs[0] + a[0] * sn[0]; v0[2] = a[2] * cs[1] - a[3] * sn[1]; v0[3] = a[3] * cs[1] + a[2] * sn[1];
                        v1[0] = b[0] * cs[2] - b[1] * sn[2]; v1[1] = b[1] * cs[2] + b[0] * sn[2]; v1[2] = b[2] * cs[3] - b[3] * sn[3]; v1[3] = b[3] * cs[3] + b[2] * sn[3]; }
                    u32x4 w; w.x = cvtpk(v0[0], v0[1]); w.y = cvtpk(v0[2], v0[3]); w.z = cvtpk(v1[0], v1[1]); w.w = cvtpk(v1[2], v1[3]);
                    *(u32x4*)(rowp + bj * HALF) = w; } }
        }
    }
};

template <class T, class = void> struct epi_rowinfo_lds { static constexpr bool value = false; };
template <class T> struct epi_rowinfo_lds<T, decltype((void)T::ROWINFO_LDS)> { static constexpr bool value = T::ROWINFO_LDS; };
template <class Epi, class Sched, bool ALIGN_EPI, bool GATHER = false>
__device__ __forceinline__ void gemm_phase(LAS unsigned char* lds, const Gemm g, const Sched& S, const Epi& E, int WV_, const int2* rowinfo = nullptr) {
    const int tid = otid(), wid = __builtin_amdgcn_readfirstlane(tid >> 6), lane = tid & 63, wr = wid >> 2, wc = wid & 3, fr = lane & 15, fq = lane >> 4;
    const int K = g.K, nt = K / BK;
    unsigned voffA[2], voffB[2], voffA1[2] = {0u, 0u}, nvoffA[2] = {0u, 0u}, nvoffA1[2] = {0u, 0u};
    int stR[2], stC[2];
#pragma unroll
    for (int i = 0; i < 2; ++i) { int R, C; stage_rc(tid * 16 + i * 8192, R, C); const int Rb = Epi::PERM ? ((R & ~31) + perm32(R & 31)) : R; stR[i] = R; stC[i] = C;
        voffA[i] = (unsigned)(R * g.lda + C) * 2u; voffB[i] = (unsigned)(Rb * g.ldb + C) * 2u; }
#define PG8_GOFF(o0, o1, pm_) do { _Pragma("unroll") for (int _i = 0; _i < 2; ++_i) { const int r0_ = (pm_) * BM + stR[_i]; const int t0_ = rowinfo[r0_].x, t1_ = rowinfo[r0_ + HALF].x; \
        (o0)[_i] = (unsigned)(((t0_ < 0 ? 0 : t0_) >> 1) * g.lda + stC[_i]) * 2u; (o1)[_i] = (unsigned)(((t1_ < 0 ? 0 : t1_) >> 1) * g.lda + stC[_i]) * 2u; } } while (0)
#define PG8_STAGE_A(bufoff, a, h, o0, o1) do { if constexpr (GATHER) { if (h) PG8_STAGE(bufoff, a, o1); else PG8_STAGE(bufoff, a, o0); } else PG8_STAGE(bufoff, (a) + (h) * hstepA, voffA); } while (0)
    const size_t kstep = (size_t)(BK * 2);
    const size_t hstepA = (size_t)HALF * g.lda * 2, hstepB = (size_t)HALF * g.ldb * 2;
    const unsigned ldsw = (unsigned)wid * 1024u;
    const int aoff = lds_byte(wr * 64 + fr, fq * 8), boff = lds_byte(wc * 32 + fr, fq * 8);
#define PG8_SA(b, h) (((b) * 2 + (h)) * HTB)
#define PG8_SB(b, h) ((4 + (b) * 2 + (h)) * HTB)
#define PG8_STAGE(bufoff, gbase, voff) do { _Pragma("unroll") for (int _i = 0; _i < 2; ++_i) \
        __builtin_amdgcn_global_load_lds((const unsigned*)((const char*)(gbase) + (voff)[_i]), (LAS unsigned*)(lds + (bufoff) + ldsw + _i * 8192), 16, 0, 0); } while (0)
#define PG8_LDA(dst, b, h) do { _Pragma("unroll") for (int m = 0; m < 4; ++m) _Pragma("unroll") for (int k = 0; k < 2; ++k) dst[m][k] = *(const LAS bf16x8*)(lds + PG8_SA(b, h) + aoff + m * 2048 + k * 1024); } while (0)
#define PG8_LDB(dst, b, h) do { _Pragma("unroll") for (int n = 0; n < 2; ++n) _Pragma("unroll") for (int k = 0; k < 2; ++k) dst[n][k] = *(const LAS bf16x8*)(lds + PG8_SB(b, h) + boff + n * 2048 + k * 1024); } while (0)
#define PG8_MMA(ai, bj, At, Bt) do { __builtin_amdgcn_s_setprio(1); _Pragma("unroll") for (int m = 0; m < 4; ++m) _Pragma("unroll") for (int n = 0; n < 2; ++n) _Pragma("unroll") for (int k = 0; k < 2; ++k) \
        acc[ai][bj][m][n] = __builtin_amdgcn_mfma_f32_16x16x32_bf16(Bt[n][k], At[m][k], acc[ai][bj][m][n], 0, 0, 0); __builtin_amdgcn_s_setprio(0); } while (0)
#define PG8_WAIT_V(n) asm volatile("s_waitcnt vmcnt(" #n ")" ::: "memory")
#define PG8_WAIT_L(n) asm volatile("s_waitcnt lgkmcnt(" #n ")" ::: "memory")
#define PG8_BAR __builtin_amdgcn_s_barrier()
#define PG8_SCHED __builtin_amdgcn_sched_barrier(0)
    Unit cur, nxt; int ui = 0;
    if (!S.next(0, cur)) return;
    f32x4 acc[2][2][4][2];
#pragma unroll
    for (int a = 0; a < 2; ++a)
#pragma unroll
        for (int b = 0; b < 2; ++b)
#pragma unroll
            for (int m = 0; m < 4; ++m)
#pragma unroll
                for (int n = 0; n < 2; ++n) acc[a][b][m][n] = (f32x4){0.f, 0.f, 0.f, 0.f};
    bf16x8 At[4][2], B0[2][2], B1[2][2];
    const char* cA = (const char*)g.A + (GATHER ? (size_t)0 : (size_t)cur.pm * 2 * hstepA); const char* cB = (const char*)g.Bt + (size_t)cur.brow * g.ldb * 2;
    if constexpr (GATHER) { PG8_GOFF(voffA, voffA1, cur.pm); }
    PG8_STAGE(PG8_SB(0, 0), cB, voffB); PG8_STAGE(PG8_SB(0, 1), cB + hstepB, voffB); PG8_STAGE_A(PG8_SA(0, 0), cA, 0, voffA, voffA1); PG8_STAGE_A(PG8_SA(0, 1), cA, 1, voffA, voffA1);
    if (wr == 1) PG8_BAR;
    PG8_WAIT_V(2); PG8_BAR;
    PG8_STAGE(PG8_SB(1, 0), cB + kstep, voffB); PG8_STAGE_A(PG8_SA(1, 0), cA + kstep, 0, voffA, voffA1); PG8_STAGE(PG8_SB(1, 1), cB + hstepB + kstep, voffB);
    PG8_WAIT_V(6); PG8_BAR;
    for (;;) {
        if constexpr (epi_rowinfo_lds<Epi>::value) {
            if (tid < 256) { const int2 rv = E.rowinfo[cur.pm * BM + tid]; ((LAS i32x2*)(lds + 132096 + (ui & 1) * 2048))[tid] = (i32x2){rv.x, rv.y}; } }
        const bool has_next = S.next(ui + 1, nxt);
        const char* nA = has_next ? (const char*)g.A + (GATHER ? (size_t)0 : (size_t)nxt.pm * 2 * hstepA) : cA; const char* nB = has_next ? (const char*)g.Bt + (size_t)nxt.brow * g.ldb * 2 : cB;
        if constexpr (GATHER) {
            if (has_next) { PG8_GOFF(nvoffA, nvoffA1, nxt.pm); } else { nvoffA[0] = voffA[0]; nvoffA[1] = voffA[1]; nvoffA1[0] = voffA1[0]; nvoffA1[1] = voffA1[1]; }
            asm volatile("s_waitcnt vmcnt(0)" : "+v"(nvoffA[0]), "+v"(nvoffA[1]), "+v"(nvoffA1[0]), "+v"(nvoffA1[1]) :: "memory"); }
        for (int t = 0; t < nt; t += 2) {
            const bool last = (t == nt - 2);
            const char* a1 = cA + (size_t)(t + 1) * kstep;
            const char* a2 = last ? nA : cA + (size_t)(t + 2) * kstep; const char* b2 = last ? nB : cB + (size_t)(t + 2) * kstep;
            const char* a3 = a2 + kstep; const char* b3 = b2 + kstep;
            unsigned xo0[2], xo1[2];
#pragma unroll
            for (int _i = 0; _i < 2; ++_i) { xo0[_i] = last ? nvoffA[_i] : voffA[_i]; xo1[_i] = last ? nvoffA1[_i] : voffA1[_i]; }
            PG8_LDB(B0, 0, 0); PG8_LDB(B1, 0, 1); PG8_SCHED; PG8_LDA(At, 0, 0); PG8_STAGE_A(PG8_SA(1, 1), a1, 1, voffA, voffA1);
            PG8_WAIT_V(8); PG8_WAIT_L(0); PG8_BAR; PG8_MMA(0, 0, At, B0); PG8_MMA(0, 1, At, B1); PG8_BAR; PG8_SCHED;
            PG8_LDA(At, 0, 1); PG8_STAGE(PG8_SB(0, 0), b2, voffB); PG8_STAGE(PG8_SB(0, 1), b2 + hstepB, voffB); PG8_STAGE_A(PG8_SA(0, 0), a2, 0, xo0, xo1);
            PG8_WAIT_V(8); PG8_WAIT_L(0); PG8_BAR; PG8_MMA(1, 0, At, B0); PG8_MMA(1, 1, At, B1); PG8_BAR; PG8_SCHED;
            PG8_LDB(B0, 1, 0); PG8_LDB(B1, 1, 1); PG8_SCHED; PG8_LDA(At, 1, 0); PG8_STAGE_A(PG8_SA(0, 1), a2, 1, xo0, xo1);
            PG8_WAIT_V(8); PG8_WAIT_L(0); PG8_BAR; PG8_MMA(0, 0, At, B0); PG8_MMA(0, 1, At, B1); PG8_BAR; PG8_SCHED;
            PG8_LDA(At, 1, 1); PG8_STAGE(PG8_SB(1, 0), b3, voffB); PG8_STAGE(PG8_SB(1, 1), b3 + hstepB, voffB); PG8_STAGE_A(PG8_SA(1, 0), a3, 0, xo0, xo1);
            PG8_WAIT_V(8); PG8_WAIT_L(0); PG8_BAR; PG8_MMA(1, 0, At, B0); PG8_MMA(1, 1, At, B1); PG8_BAR; PG8_SCHED;
        }
        if constexpr (ALIGN_EPI) { if (wr == 0) PG8_BAR; }
        if constexpr (epi_rowinfo_lds<Epi>::value) E(acc, cur, wr, wc, fr, fq, (const LAS i32x2*)(lds + 132096 + (ui & 1) * 2048));
        else E(acc, cur, wr, wc, fr, fq);
        if (!has_next) break;
#pragma unroll
        for (int a = 0; a < 2; ++a)
#pragma unroll
            for (int b = 0; b < 2; ++b)
#pragma unroll
                for (int m = 0; m < 4; ++m)
#pragma unroll
                    for (int n = 0; n < 2; ++n) acc[a][b][m][n] = (f32x4){0.f, 0.f, 0.f, 0.f};
        cur = nxt; cA = nA; cB = nB; ++ui;
        if constexpr (GATHER) { voffA[0] = nvoffA[0]; voffA[1] = nvoffA[1]; voffA1[0] = nvoffA1[0]; voffA1[1] = nvoffA1[1]; }
        if constexpr (ALIGN_EPI) { if (wr == 1) PG8_BAR; }
    }
    PG8_WAIT_V(0);
    if constexpr (!ALIGN_EPI) { if (wr == 0) PG8_BAR; }
    PG8_BAR;
#undef PG8_SA
#undef PG8_SB
#undef PG8_STAGE
#undef PG8_STAGE_A
#undef PG8_GOFF
#undef PG8_LDA
#undef PG8_LDB
#undef PG8_MMA
#undef PG8_WAIT_V
#undef PG8_WAIT_L
#undef PG8_BAR
#undef PG8_SCHED
}
}

namespace att {
constexpr int NW = 8, QBLK = 32, KVBLK = 64;
constexpr float THR = 8.f;
constexpr size_t SHM_V = KVBLK * 128 * 2, SHM_K = KVBLK * 128 * 2, SHM_ATTN = 2 * SHM_V + 2 * SHM_K + NW * 64 * 4;
#define KSWZ(row, colB) ((row) * 256 + ((colB) ^ (((row) & 7) << 4)))
#define KSWZ64(row, colB) ((row) * 128 + ((colB) ^ (((row) & 7) << 4)))
#define SBAR() __builtin_amdgcn_sched_barrier(0)
__device__ __forceinline__ int crow(int r, int hi) { return (r & 3) + 8 * (r >> 2) + 4 * hi; }
__device__ __forceinline__ bf16x8 ld8(const bf16_t* p) { return *reinterpret_cast<const bf16x8*>(p); }

__device__ __forceinline__ void partialSM(f32x16& p0, f32x16& p1, float& m_reg, float& mn, float& alpha, float C, float thr_raw) {
  float pmax = p0[0];
#pragma unroll
  for (int r = 1; r < 16; ++r) pmax = fmaxf(pmax, p0[r]);
#pragma unroll
  for (int r = 0; r < 16; ++r) pmax = fmaxf(pmax, p1[r]);
  { auto rr = __builtin_amdgcn_permlane32_swap(__float_as_uint(pmax), __float_as_uint(pmax), false, false);
    pmax = fmaxf(__uint_as_float(rr[0]), __uint_as_float(rr[1])); }
  if (__builtin_expect(__all(pmax - m_reg <= thr_raw), 1)) { mn = m_reg; alpha = 1.f; }
  else { mn = fmaxf(m_reg, pmax); alpha = __builtin_amdgcn_exp2f((m_reg - mn) * C); m_reg = mn; }
  float mnC = -mn * C;
#pragma unroll
  for (int r = 0; r < 16; ++r) p0[r] = fmaf(p0[r], C, mnC);
#pragma unroll
  for (int r = 0; r < 16; ++r) p1[r] = fmaf(p1[r], C, mnC);
#pragma unroll
  for (int r = 0; r < 16; ++r) p0[r] = __builtin_amdgcn_exp2f(p0[r]);
}
#define PK4(P, BASE, OUT) do { u32x4 w = {cvtpk(P[BASE + 0], P[BASE + 1]), cvtpk(P[BASE + 2], P[BASE + 3]), cvtpk(P[BASE + 4], P[BASE + 5]), cvtpk(P[BASE + 6], P[BASE + 7])}; \
    OUT = *reinterpret_cast<bf16x8*>(&w); } while (0)
__device__ __forceinline__ void finishSM(f32x16& p0, f32x16& p1, bf16x8& pa0, bf16x8& pa1, bf16x8& pa2, bf16x8& pa3) {
#pragma unroll
  for (int r = 0; r < 16; ++r) p1[r] = __builtin_amdgcn_exp2f(p1[r]);
  PK4(p0, 0, pa0); PK4(p0, 8, pa1); PK4(p1, 0, pa2); PK4(p1, 8, pa3);
}
template <int D0_LO, int D0_HI>
__device__ __forceinline__ void qkt(f32x16& p0, f32x16& p1, const bf16_t* Ks, const bf16x8* qr, int r32, int hi) {
  p0 = f32x16{}; p1 = f32x16{};
#pragma unroll
  for (int d0 = D0_LO; d0 < D0_HI; ++d0) { int cb = (d0 * 16 + hi * 8) * 2;
    bf16x8 b0 = *reinterpret_cast<const bf16x8*>((const char*)Ks + KSWZ(r32, cb));
    bf16x8 b1 = *reinterpret_cast<const bf16x8*>((const char*)Ks + KSWZ(32 + r32, cb));
    p0 = __builtin_amdgcn_mfma_f32_32x32x16_bf16(b0, qr[d0], p0, 0, 0, 0);
    p1 = __builtin_amdgcn_mfma_f32_32x32x16_bf16(b1, qr[d0], p1, 0, 0, 0); }
}
__device__ __forceinline__ void qkt64(f32x16& p0, f32x16& p1, const bf16_t* Ks, const bf16x8* qr, int r32, int hi) {
  p0 = f32x16{}; p1 = f32x16{};
#pragma unroll
  for (int d0 = 0; d0 < 4; ++d0) { int cb = (d0 * 16 + hi * 8) * 2;
    bf16x8 b0 = *reinterpret_cast<const bf16x8*>((const char*)Ks + KSWZ64(r32, cb));
    bf16x8 b1 = *reinterpret_cast<const bf16x8*>((const char*)Ks + KSWZ64(32 + r32, cb));
    p0 = __builtin_amdgcn_mfma_f32_32x32x16_bf16(b0, qr[d0], p0, 0, 0, 0);
    p1 = __builtin_amdgcn_mfma_f32_32x32x16_bf16(b1, qr[d0], p1, 0, 0, 0); }
}
__device__ __forceinline__ int v_st(int k, int c) { const int kk = k; return ((kk >> 3) * 4 + (c >> 5)) * 512 + ((kk & 7) * 32 + (c & 31)) * 2; }
__device__ __forceinline__ int v_rd_base(int lane) { return ((lane & 3) << 3) | (((lane >> 2) & 3) << 6) | (((lane >> 4) & 1) << 5) | (((lane >> 5) & 1) << 8); }
__host__ __device__ constexpr int v_rd_off(int d0, int ks, int half) { return d0 * 512 + ks * 4096 + half * 2048; }
template <int OFF> __device__ __forceinline__ s16x4 tr_read(int vb) {
  s16x4 r; asm volatile("ds_read_b64_tr_b16 %0, %1 offset:%2" : "=&v"(r) : "v"(vb), "i"(OFF) : "memory"); return r;
}
template <int D0> __device__ __forceinline__ void pv_one(f32x16& od, int vb, bf16x8 pa0, bf16x8 pa1, bf16x8 pa2, bf16x8 pa3) {
  const s16x4 l0 = tr_read<v_rd_off(D0, 0, 0)>(vb), h0 = tr_read<v_rd_off(D0, 0, 1)>(vb), l1 = tr_read<v_rd_off(D0, 1, 0)>(vb), h1 = tr_read<v_rd_off(D0, 1, 1)>(vb);
  const s16x4 l2 = tr_read<v_rd_off(D0, 2, 0)>(vb), h2 = tr_read<v_rd_off(D0, 2, 1)>(vb), l3 = tr_read<v_rd_off(D0, 3, 0)>(vb), h3 = tr_read<v_rd_off(D0, 3, 1)>(vb);
  asm volatile("s_waitcnt lgkmcnt(0)" ::: "memory"); SBAR();
#define PKV(L, H) (bf16x8){L[0], L[1], L[2], L[3], H[0], H[1], H[2], H[3]}
  od = __builtin_amdgcn_mfma_f32_32x32x16_bf16(pa0, PKV(l0, h0), od, 0, 0, 0);
  od = __builtin_amdgcn_mfma_f32_32x32x16_bf16(pa1, PKV(l1, h1), od, 0, 0, 0);
  od = __builtin_amdgcn_mfma_f32_32x32x16_bf16(pa2, PKV(l2, h2), od, 0, 0, 0);
  od = __builtin_amdgcn_mfma_f32_32x32x16_bf16(pa3, PKV(l3, h3), od, 0, 0, 0);
}
__device__ __forceinline__ void pv_l(f32x16* o, f32x16& l, int vb, bf16x8 pa0, bf16x8 pa1, bf16x8 pa2, bf16x8 pa3) {
  const bf16x8 ones = {0x3F80, 0x3F80, 0x3F80, 0x3F80, 0x3F80, 0x3F80, 0x3F80, 0x3F80};
  pv_one<0>(o[0], vb, pa0, pa1, pa2, pa3); l = __builtin_amdgcn_mfma_f32_32x32x16_bf16(pa0, ones, l, 0, 0, 0);
  pv_one<1>(o[1], vb, pa0, pa1, pa2, pa3); l = __builtin_amdgcn_mfma_f32_32x32x16_bf16(pa1, ones, l, 0, 0, 0);
  pv_one<2>(o[2], vb, pa0, pa1, pa2, pa3); l = __builtin_amdgcn_mfma_f32_32x32x16_bf16(pa2, ones, l, 0, 0, 0);
  pv_one<3>(o[3], vb, pa0, pa1, pa2, pa3); l = __builtin_amdgcn_mfma_f32_32x32x16_bf16(pa3, ones, l, 0, 0, 0);
}
__device__ __forceinline__ void pv_d0(f32x16* o, int vb, bf16x8 pa0, bf16x8 pa1, bf16x8 pa2, bf16x8 pa3) {
  pv_one<0>(o[0], vb, pa0, pa1, pa2, pa3); pv_one<1>(o[1], vb, pa0, pa1, pa2, pa3); pv_one<2>(o[2], vb, pa0, pa1, pa2, pa3); pv_one<3>(o[3], vb, pa0, pa1, pa2, pa3);
}

template <int D0_LO, int D0_HI, typename TO, bool DIFF = false>
__device__ __forceinline__ void attn_dense_body(const bf16_t* __restrict__ Qb, int ldq, const bf16_t* __restrict__ Kh, int ldk, const bf16_t* __restrict__ Vh, int ldv,
                                                TO* __restrict__ Ob, int ldo, int seq, float scale, char* lds,
                                                int WV_, const float* OA = nullptr, int ldoa = 0, float lam = 0.f, const float* subln = nullptr, const bf16_t* QN = nullptr, int ldqn = 0) {
  const int tid = otid(), wid = tid >> 6, lane = tid & 63, r32 = lane & 31, hi = lane >> 5;
  float C = scale * 1.4426950408889634f, thr_raw = THR / scale;
  if (QN) {
    const bf16_t* qn = QN + (long)(wid * QBLK + r32) * ldqn + hi * 128; float ss = 0.f;
#pragma unroll
    for (int q = 0; q < 16; ++q) { const u32x4 w = *(const u32x4*)(qn + q * 8); const float a0 = bflo(w.x), a1 = bfhi(w.x), a2 = bflo(w.y), a3 = bfhi(w.y), a4 = bflo(w.z), a5 = bfhi(w.z), a6 = bflo(w.w), a7 = bfhi(w.w);
      ss += (a0 * a0 + a1 * a1) + (a2 * a2 + a3 * a3) + (a4 * a4 + a5 * a5) + (a6 * a6 + a7 * a7); }
    ss += __shfl_xor(ss, 32);
    const float rq = 1.f / sqrtf(ss * (1.f / 256.f) + 1e-6f); C *= rq; thr_raw /= rq; }
  bf16_t* V_lds = (bf16_t*)lds; bf16_t* K_lds = (bf16_t*)(lds + 2 * SHM_V);
  float* ws = (float*)(lds + 2 * SHM_V + 2 * SHM_K) + wid * 64; float* al_l = ws + 32;
  float m_reg = -1e30f; f32x16 o[4] = {}; f32x16 lacc = {}; bf16x8 qr[8];
  const bf16_t* Qw = Qb + (long)(wid * QBLK + r32) * ldq + hi * 8;
#pragma unroll
  for (int d0 = 0; d0 < 8; ++d0) qr[d0] = (d0 >= D0_LO && d0 < D0_HI) ? ld8(Qw + d0 * 16) : bf16x8{};
  const int sr = tid >> 4, sc = (tid & 15) * 8, vst0 = v_st(sr, sc), vst1 = v_st(32 + sr, sc);
  const int vb0 = (int)(uintptr_t)V_lds + v_rd_base(lane);
  struct { bf16x8 vs0, vs1, ks0, ks1; } sr_[2];
#define SLOAD(i, k0) do { sr_[i].vs0 = ld8(&Vh[(long)((k0) + sr) * ldv + sc]); sr_[i].vs1 = ld8(&Vh[(long)((k0) + 32 + sr) * ldv + sc]); \
    sr_[i].ks0 = ld8(&Kh[(long)((k0) + sr) * ldk + sc]); sr_[i].ks1 = ld8(&Kh[(long)((k0) + 32 + sr) * ldk + sc]); } while (0)
#define SWRITE(b, i) do { *(bf16x8*)((char*)V_lds + (b) * SHM_V + vst0) = sr_[i].vs0;          \
    *(bf16x8*)((char*)V_lds + (b) * SHM_V + vst1) = sr_[i].vs1; int kc = sc * 2;               \
    *(bf16x8*)((char*)K_lds + (b) * SHM_K + KSWZ(sr, kc)) = sr_[i].ks0;                       \
    *(bf16x8*)((char*)K_lds + (b) * SHM_K + KSWZ(32 + sr, kc)) = sr_[i].ks1; } while (0)
#define SWAIT() asm volatile("s_waitcnt vmcnt(4)" ::: "memory")
#define RESC(a) do { if (__any((a) < 1.f)) { if (hi == 0) al_l[r32] = (a); asm volatile("s_waitcnt lgkmcnt(0)" ::: "memory"); \
    _Pragma("unroll") for (int r = 0; r < 16; ++r) { const float av = al_l[crow(r, hi)]; lacc[r] *= av; _Pragma("unroll") for (int d = 0; d < 4; ++d) o[d][r] *= av; } } } while (0)
  f32x16 pA0, pA1, pB0, pB1; float mnA, mnB, alA, alB; bf16x8 pa0, pa1, pa2, pa3; const int NT = seq / KVBLK;
  constexpr int SE = 0, SO = 1;
  SLOAD(SE, 0); asm volatile("s_waitcnt vmcnt(0)" ::: "memory"); SWRITE(0, SE); __syncthreads();
  qkt<D0_LO, D0_HI>(pA0, pA1, K_lds, qr, r32, hi); partialSM(pA0, pA1, m_reg, mnA, alA, C, thr_raw);
  SLOAD(SO, KVBLK); if (2 < NT) SLOAD(SE, 2 * KVBLK);
  SWAIT(); SWRITE(1, SO); __syncthreads();
  for (int j = 1; j + 1 < NT; j += 2) {
    SBAR(); qkt<D0_LO, D0_HI>(pB0, pB1, (bf16_t*)((char*)K_lds + SHM_K), qr, r32, hi);
    finishSM(pA0, pA1, pa0, pa1, pa2, pa3); SBAR();
    SLOAD(SO, (j + 2) * KVBLK); SBAR();
    pv_l(o, lacc, vb0, pa0, pa1, pa2, pa3); partialSM(pB0, pB1, m_reg, mnB, alB, C, thr_raw);
    __syncthreads(); SWAIT(); SWRITE(0, SE);
    RESC(alB); __syncthreads();
    SBAR(); qkt<D0_LO, D0_HI>(pA0, pA1, K_lds, qr, r32, hi);
    finishSM(pB0, pB1, pa0, pa1, pa2, pa3); SBAR();
    if (j + 3 < NT) SLOAD(SE, (j + 3) * KVBLK); SBAR();
    pv_l(o, lacc, vb0 + (int)SHM_V, pa0, pa1, pa2, pa3); partialSM(pA0, pA1, m_reg, mnA, alA, C, thr_raw);
    __syncthreads(); SWAIT(); SWRITE(1, SO);
    RESC(alA); __syncthreads();
  }
  SBAR(); qkt<D0_LO, D0_HI>(pB0, pB1, (bf16_t*)((char*)K_lds + SHM_K), qr, r32, hi);
  finishSM(pA0, pA1, pa0, pa1, pa2, pa3); SBAR();
  pv_l(o, lacc, vb0, pa0, pa1, pa2, pa3); partialSM(pB0, pB1, m_reg, mnB, alB, C, thr_raw);
  __syncthreads(); RESC(alB);
  finishSM(pB0, pB1, pa0, pa1, pa2, pa3); SBAR();
  pv_l(o, lacc, vb0 + (int)SHM_V, pa0, pa1, pa2, pa3);
  float rli[16];
#pragma unroll
  for (int r = 0; r < 16; ++r) rli[r] = __builtin_amdgcn_rcpf(lacc[r]);
  TO* Ow = Ob + (long)(wid * QBLK) * ldo;
  if constexpr (DIFF) {
    const float* OA2 = OA; asm volatile("" : "+s"(OA2));
    const float* OAw = OA2 + (long)(wid * QBLK) * ldoa;
    float sg[4];
#pragma unroll
    for (int d0 = 0; d0 < 4; ++d0) sg[d0] = subln[d0 * 32 + r32] * 0.8f;
#pragma unroll
    for (int r = 0; r < 16; ++r) { int orow = crow(r, hi); float ov[4]; float ss = 0.f;
#pragma unroll
      for (int d0 = 0; d0 < 4; ++d0) { const float va = OAw[(long)orow * ldoa + d0 * 32 + r32]; ov[d0] = va - lam * (o[d0][r] * rli[r]); ss += ov[d0] * ov[d0]; }
      ss = half_sum(ss); const float rs = 1.f / sqrtf(ss * (1.f / 128.f) + 1e-6f);
#pragma unroll
      for (int d0 = 0; d0 < 4; ++d0) Ow[(long)orow * ldo + d0 * 32 + r32] = (TO)f2bf(ov[d0] * rs * sg[d0]); }
  } else {
#pragma unroll
  for (int r = 0; r < 16; ++r) { int orow = crow(r, hi);
#pragma unroll
    for (int d0 = 0; d0 < 4; ++d0) { const float val = o[d0][r] * rli[r];
      if constexpr (sizeof(TO) == 4) Ow[(long)orow * ldo + d0 * 32 + r32] = val; else Ow[(long)orow * ldo + d0 * 32 + r32] = (TO)f2bf(val); } }
  }
  __syncthreads();
#undef SLOAD
#undef SWRITE
#undef SWAIT
#undef RESC
}
}

namespace chk {
using att::crow; using att::v_st; using att::v_rd_base; using att::v_rd_off;
struct Cfg {
    const bf16_t* Z; int ld;
    int qcol, kcol, vcol, gcol;
    const float* BF; const float* BB;
    const float* dec_f; const float* dec_b;
    float qscale;
    bf16_t* U;
    bf16_t* OUT; int ldo; int ocol;
    const float* gain;
};
__device__ __forceinline__ s16x4 vtr(const LAS char* p) { return __builtin_bit_cast(s16x4, __builtin_amdgcn_ds_read_tr16_b64_v4i16((LAS v4i16_t*)p)); }
__device__ __forceinline__ bf16x8 trfrag(const LAS char* base, int d0, int ks) {
    const s16x4 l = vtr(base + v_rd_off(d0, ks, 0)), h = vtr(base + v_rd_off(d0, ks, 1));
    return (bf16x8){l[0], l[1], l[2], l[3], h[0], h[1], h[2], h[3]};
}
__device__ __forceinline__ void unpack8w(const u32x4 w, float* f) { f[0] = bflo(w.x); f[1] = bfhi(w.x); f[2] = bflo(w.y); f[3] = bfhi(w.y); f[4] = bflo(w.z); f[5] = bfhi(w.z); f[6] = bflo(w.w); f[7] = bfhi(w.w); }
__device__ __forceinline__ u32x4 scale8(u32x4 w, const float* s) {
    u32x4 o; o.x = cvtpk(bflo(w.x) * s[0], bfhi(w.x) * s[1]); o.y = cvtpk(bflo(w.y) * s[2], bfhi(w.y) * s[3]);
    o.z = cvtpk(bflo(w.z) * s[4], bfhi(w.z) * s[5]); o.w = cvtpk(bflo(w.w) * s[6], bfhi(w.w) * s[7]); return o;
}
__device__ __forceinline__ u32x4 scale8s(u32x4 w, float s) {
    u32x4 o; o.x = cvtpk(bflo(w.x) * s, bfhi(w.x) * s); o.y = cvtpk(bflo(w.y) * s, bfhi(w.y) * s);
    o.z = cvtpk(bflo(w.z) * s, bfhi(w.z) * s); o.w = cvtpk(bflo(w.w) * s, bfhi(w.w) * s); return o;
}

template <int DK, bool RET>
__device__ __forceinline__ void chunk_states(const Cfg& cf, char* lds, int unit, int WV_) {
    const int tid = otid(), wid = tid >> 6, lane = tid & 63, r32 = lane & 31, hi = lane >> 5;
    const int b = unit >> 7, c = unit & 127; const long row_base = (long)b * SEQ + (long)c * 64;
    constexpr int KG = DK / 8;
    const LAS char* L = (const LAS char*)lds;
    for (int hp = 0; hp < 2; ++hp) {
#pragma unroll
        for (int i = 0; i < 4; ++i) { const int p = tid + 512 * i, hl = p >> 10, row = (p >> 4) & 63, cg = p & 15, h = hp * 2 + hl;
            const bf16x8 v = att::ld8(cf.Z + (row_base + row) * cf.ld + cf.vcol + h * 128 + cg * 8);
            *(bf16x8*)(lds + hl * 16384 + v_st(row, cg * 8)) = v; }
#pragma unroll
        for (int i = 0; i < (2 * 64 * KG) / 512; ++i) { const int p = tid + 512 * i, hl = p / (64 * KG), row = (p / KG) % 64, cg = p % KG, h = hp * 2 + hl;
            const u32x4 kw = *(const u32x4*)(cf.Z + (row_base + row) * cf.ld + cf.kcol + h * DK + cg * 8);
            u32x4 kf, kb;
            if constexpr (RET) { const float laf = -__expf(cf.dec_f[h]), lab = -__expf(cf.dec_b[h]);
                kf = scale8s(kw, __expf((float)(63 - row) * laf)); kb = scale8s(kw, __expf((float)row * lab)); }
            else { const int col = h * 64 + cg * 8; float wf[8], wb[8];
                const f32x4 fl0 = *(const f32x4*)(cf.BF + (row_base + 63) * 256 + col), fl1 = *(const f32x4*)(cf.BF + (row_base + 63) * 256 + col + 4);
                const f32x4 fs0 = *(const f32x4*)(cf.BF + (row_base + row) * 256 + col), fs1 = *(const f32x4*)(cf.BF + (row_base + row) * 256 + col + 4);
                const f32x4 bl0 = *(const f32x4*)(cf.BB + row_base * 256 + col), bl1 = *(const f32x4*)(cf.BB + row_base * 256 + col + 4);
                const f32x4 bs0 = *(const f32x4*)(cf.BB + (row_base + row) * 256 + col), bs1 = *(const f32x4*)(cf.BB + (row_base + row) * 256 + col + 4);
#pragma unroll
                for (int j = 0; j < 4; ++j) { wf[j] = __expf(fl0[j] - fs0[j]); wf[4 + j] = __expf(fl1[j] - fs1[j]); wb[j] = __expf(bl0[j] - bs0[j]); wb[4 + j] = __expf(bl1[j] - bs1[j]); }
                kf = scale8(kw, wf); kb = scale8(kw, wb); }
            *(u32x4*)(lds + 32768 + hl * 16384 + v_st(row, cg * 8)) = kf;
            *(u32x4*)(lds + 65536 + hl * 16384 + v_st(row, cg * 8)) = kb; }
        __syncthreads();
        {
            const int hl = wid >> 2, dir = (wid >> 1) & 1, vh = wid & 1, h = hp * 2 + hl;
            const LAS char* vbV = L + hl * 16384 + v_rd_base(lane);
            const LAS char* vbK = L + 32768 + dir * 32768 + hl * 16384 + v_rd_base(lane);
            bf16_t* Ub = cf.U + ((((size_t)(b * 128 + c) * 4 + h) * 2 + dir) * 128) * DK;
#pragma unroll
            for (int ii = 0; ii < 2; ++ii) {
                f32x16 acc[DK / 32];
#pragma unroll
                for (int j = 0; j < DK / 32; ++j) acc[j] = f32x16{};
#pragma unroll
                for (int ks = 0; ks < 4; ++ks) {
                    const bf16x8 af = trfrag(vbV, vh * 2 + ii, ks);
#pragma unroll
                    for (int j = 0; j < DK / 32; ++j) { const bf16x8 bfr = trfrag(vbK, j, ks); acc[j] = __builtin_amdgcn_mfma_f32_32x32x16_bf16(af, bfr, acc[j], 0, 0, 0); }
                }
#pragma unroll
                for (int j = 0; j < DK / 32; ++j)
#pragma unroll
                    for (int r = 0; r < 16; ++r) Ub[(size_t)(32 * (vh * 2 + ii) + crow(r, hi)) * DK + 32 * j + r32] = f2bf(acc[j][r]);
                SBAR();
            }
        }
        __syncthreads();
    }
}

template <int DK, bool RET>
__device__ __forceinline__ void chunk_scan(const Cfg& cf, int chain) {
    constexpr int KH = DK / 2, NCH = 2 * 4 * 2 * 128 * KH;
    if (chain >= NCH) return;
    const int k2 = chain % KH, v = (chain / KH) % 128, dir = (chain / (KH * 128)) % 2, h = (chain / (KH * 256)) % 4, b = chain / (KH * 1024);
    const size_t cstride = (size_t)4 * 2 * 128 * DK;
    bf16_t* base = cf.U + ((((size_t)(b * 128) * 4 + h) * 2 + dir) * 128 + v) * DK + k2 * 2;
    float s0 = 0.f, s1 = 0.f, dsc = 0.f;
    if constexpr (RET) dsc = __expf(-64.f * __expf(dir ? cf.dec_b[h] : cf.dec_f[h]));
    constexpr int PF = 32;
    for (int c0 = 0; c0 < 128; c0 += PF) {
        unsigned u[PF]; f32x2 d[PF];
#pragma unroll
        for (int i = 0; i < PF; ++i) { const int c = dir ? (127 - c0 - i) : (c0 + i);
            u[i] = *(const unsigned*)(base + (size_t)c * cstride);
            if constexpr (!RET) d[i] = *(const f32x2*)((dir ? cf.BB + ((long)b * SEQ + c * 64) * 256 : cf.BF + ((long)b * SEQ + c * 64 + 63) * 256) + h * 64 + k2 * 2); }
#pragma unroll
        for (int i = 0; i < PF; ++i) { const int c = dir ? (127 - c0 - i) : (c0 + i);
            *(unsigned*)(base + (size_t)c * cstride) = cvtpk(s0, s1);
            float dd0 = dsc, dd1 = dsc;
            if constexpr (!RET) { dd0 = __expf(d[i][0]); dd1 = __expf(d[i][1]); }
            s0 = fmaf(dd0, s0, bflo(u[i])); s1 = fmaf(dd1, s1, bfhi(u[i])); }
    }
}

template <int DK, bool RET>
__device__ __forceinline__ void chunk_out(const Cfg& cf, char* lds, int unit, int WV_) {
    const int tid = otid(), wid = tid >> 6, lane = tid & 63, r32 = lane & 31, hi = lane >> 5;
    const int b = unit >> 7, c = unit & 127; const long row_base = (long)b * SEQ + (long)c * 64;
    constexpr int KG = DK / 8, ND0 = DK / 16, NKP = (4 * 64 * KG) / 512;
    {
        bf16x8 vv[8];
#pragma unroll
        for (int i = 0; i < 8; ++i) { const int p = tid + 512 * i, h = p >> 10, row = (p >> 4) & 63, cg = p & 15; vv[i] = att::ld8(cf.Z + (row_base + row) * cf.ld + cf.vcol + h * 128 + cg * 8); }
#pragma unroll
        for (int i = 0; i < 8; ++i) { const int p = tid + 512 * i, h = p >> 10, row = (p >> 4) & 63, cg = p & 15; *(bf16x8*)(lds + h * 16384 + v_st(row, cg * 8)) = vv[i]; }
    }
    {
        u32x4 kw[NKP];
#pragma unroll
        for (int i = 0; i < NKP; ++i) { const int p = tid + 512 * i, h = p / (64 * KG), row = (p / KG) % 64, cg = p % KG; kw[i] = *(const u32x4*)(cf.Z + (row_base + row) * cf.ld + cf.kcol + h * DK + cg * 8); }
        if constexpr (RET) {
#pragma unroll
            for (int i = 0; i < NKP; ++i) { const int p = tid + 512 * i, h = p / (64 * KG), row = (p / KG) % 64, cg = p % KG; *(u32x4*)(lds + 65536 + h * 16384 + KSWZ(row, cg * 16)) = kw[i]; }
        } else {
            f32x4 fs[NKP][2], bs[NKP][2];
#pragma unroll
            for (int i = 0; i < NKP; ++i) { const int p = tid + 512 * i, h = p / (64 * KG), row = (p / KG) % 64, cg = p % KG, col = h * 64 + cg * 8;
                fs[i][0] = *(const f32x4*)(cf.BF + (row_base + row) * 256 + col); fs[i][1] = *(const f32x4*)(cf.BF + (row_base + row) * 256 + col + 4);
                bs[i][0] = *(const f32x4*)(cf.BB + (row_base + row) * 256 + col); bs[i][1] = *(const f32x4*)(cf.BB + (row_base + row) * 256 + col + 4); }
#pragma unroll
            for (int i = 0; i < NKP; ++i) { const int p = tid + 512 * i, h = p / (64 * KG), row = (p / KG) % 64, cg = p % KG; float wf[8], wb[8];
#pragma unroll
                for (int jj = 0; jj < 4; ++jj) { wf[jj] = __expf(-fs[i][0][jj]); wf[4 + jj] = __expf(-fs[i][1][jj]); wb[jj] = __expf(-bs[i][0][jj]); wb[4 + jj] = __expf(-bs[i][1][jj]); }
                *(u32x4*)(lds + 65536 + h * 8192 + KSWZ64(row, cg * 16)) = scale8(kw[i], wf);
                *(u32x4*)(lds + 98304 + h * 8192 + KSWZ64(row, cg * 16)) = scale8(kw[i], wb); }
        }
    }
    __syncthreads();
    const int h = wid >> 1, rh = wid & 1, t = rh * 32 + r32;
    const long grow = row_base + t;
    bf16x8 qr[ND0];
#pragma unroll
    for (int d0 = 0; d0 < ND0; ++d0) qr[d0] = att::ld8(cf.Z + grow * cf.ld + cf.qcol + h * DK + d0 * 16 + hi * 8);
    f32x16 o[4] = {};
    float laf = 0.f, lab = 0.f;
    if constexpr (RET) { laf = -__expf(cf.dec_f[h]); lab = -__expf(cf.dec_b[h]); }
    bf16x8 qf[RET ? 1 : ND0], qb[RET ? 1 : ND0];
    if constexpr (!RET) {
#pragma unroll
        for (int d0 = 0; d0 < ND0; ++d0) { const int col = h * 64 + d0 * 16 + hi * 8; float ef[8], eb[8];
            const f32x4 f0 = *(const f32x4*)(cf.BF + grow * 256 + col), f1 = *(const f32x4*)(cf.BF + grow * 256 + col + 4);
            const f32x4 b0 = *(const f32x4*)(cf.BB + grow * 256 + col), b1 = *(const f32x4*)(cf.BB + grow * 256 + col + 4);
#pragma unroll
            for (int jj = 0; jj < 4; ++jj) { ef[jj] = __expf(f0[jj]) * cf.qscale; ef[4 + jj] = __expf(f1[jj]) * cf.qscale; eb[jj] = __expf(b0[jj]) * cf.qscale; eb[4 + jj] = __expf(b1[jj]) * cf.qscale; }
            const u32x4 qw = __builtin_bit_cast(u32x4, qr[d0]);
            qf[d0] = __builtin_bit_cast(bf16x8, scale8(qw, ef)); qb[d0] = __builtin_bit_cast(bf16x8, scale8(qw, eb)); }
    }
#pragma unroll
    for (int dir = 0; dir < 2; ++dir) {
        const bf16_t* Sb = cf.U + ((((size_t)(b * 128 + c) * 4 + h) * 2 + dir) * 128) * DK;
        float rs = 1.f;
        if constexpr (RET) rs = dir ? __expf((float)(64 - t) * lab) : __expf((float)(t + 1) * laf);
#pragma unroll
        for (int d2 = 0; d2 < ND0; d2 += 2) {
            bf16x8 bfr[2][4];
#pragma unroll
            for (int dd = 0; dd < 2; ++dd)
#pragma unroll
                for (int jv = 0; jv < 4; ++jv) bfr[dd][jv] = att::ld8(Sb + (size_t)(32 * jv + r32) * DK + (d2 + dd) * 16 + hi * 8);
#pragma unroll
            for (int dd = 0; dd < 2; ++dd) { const int d0 = d2 + dd; bf16x8 a;
                if constexpr (RET) a = __builtin_bit_cast(bf16x8, scale8s(__builtin_bit_cast(u32x4, qr[d0]), rs));
                else a = dir ? qb[d0] : qf[d0];
#pragma unroll
                for (int jv = 0; jv < 4; ++jv) o[jv] = __builtin_amdgcn_mfma_f32_32x32x16_bf16(a, bfr[dd][jv], o[jv], 0, 0, 0); }
            SBAR();
        }
    }
    f32x16 p0, p1;
    if constexpr (RET) {
        att::qkt<0, 8>(p0, p1, (const bf16_t*)(lds + 65536 + h * 16384), qr, r32, hi);
#pragma unroll
        for (int r = 0; r < 16; ++r) { const int s0 = crow(r, hi), s1 = 32 + s0;
            p0[r] *= (s0 <= t) ? __expf((float)(t - s0) * laf) : __expf((float)(s0 - t) * lab);
            p1[r] *= (s1 <= t) ? __expf((float)(t - s1) * laf) : __expf((float)(s1 - t) * lab); }
    } else {
        f32x16 q0, q1;
        att::qkt64(p0, p1, (const bf16_t*)(lds + 65536 + h * 8192), qf, r32, hi);
        att::qkt64(q0, q1, (const bf16_t*)(lds + 98304 + h * 8192), qb, r32, hi);
#pragma unroll
        for (int r = 0; r < 16; ++r) { const int s0 = crow(r, hi), s1 = 32 + s0;
            p0[r] = (s0 <= t) ? p0[r] : q0[r]; p1[r] = (s1 <= t) ? p1[r] : q1[r]; }
    }
    bf16x8 pa0, pa1, pa2, pa3;
    PK4(p0, 0, pa0); PK4(p0, 8, pa1); PK4(p1, 0, pa2); PK4(p1, 8, pa3);
    att::pv_d0(o, (int)(uintptr_t)lds + h * 16384 + v_rd_base(lane), pa0, pa1, pa2, pa3);
    float gn[4] = {1.f, 1.f, 1.f, 1.f};
    if constexpr (!RET) {
#pragma unroll
        for (int jv = 0; jv < 4; ++jv) gn[jv] = cf.gain[32 * jv + r32];
    }
    __syncthreads();
    bf16_t* Yt = (bf16_t*)(lds + 65536 + h * 16384);
#pragma unroll
    for (int r = 0; r < 16; ++r) { const int orow = rh * 32 + crow(r, hi);
        float y[4];
        if constexpr (RET) {
            const float mu = half_sum((o[0][r] + o[1][r]) + (o[2][r] + o[3][r])) * (1.f / 128.f);
            float q = 0.f;
#pragma unroll
            for (int jv = 0; jv < 4; ++jv) { y[jv] = o[jv][r] - mu; q += y[jv] * y[jv]; }
            const float rstd = 1.f / sqrtf(half_sum(q) * (1.f / 128.f) + 1e-5f);
#pragma unroll
            for (int jv = 0; jv < 4; ++jv) y[jv] *= rstd;
        } else {
            float q = 0.f;
#pragma unroll
            for (int jv = 0; jv < 4; ++jv) q += o[jv][r] * o[jv][r];
            const float rstd = 1.f / sqrtf(half_sum(q) * (1.f / 128.f) + 1e-6f);
#pragma unroll
            for (int jv = 0; jv < 4; ++jv) y[jv] = o[jv][r] * rstd * gn[jv];
        }
#pragma unroll
        for (int jv = 0; jv < 4; ++jv) Yt[orow * 128 + 32 * jv + r32] = f2bf(y[jv]);
    }
    __syncthreads();
    {
        const int tid2 = otid();
        u32x4 gw8[8];
#pragma unroll
        for (int i = 0; i < 8; ++i) { const int p = tid2 + 512 * i, hh = p >> 10, row = (p >> 4) & 63, cg = p & 15; gw8[i] = *(const u32x4*)(cf.Z + (row_base + row) * cf.ld + cf.gcol + hh * 128 + cg * 8); }
#pragma unroll
        for (int i = 0; i < 8; ++i) { const int p = tid2 + 512 * i, hh = p >> 10, row = (p >> 4) & 63, cg = p & 15;
            const u32x4 yw = *(const u32x4*)(lds + 65536 + hh * 16384 + row * 256 + cg * 16);
            float yf[8], gf[8]; unpack8w(yw, yf); unpack8w(gw8[i], gf);
#pragma unroll
            for (int e = 0; e < 8; ++e) yf[e] *= silu_f(gf[e]);
            u32x4 ow; ow.x = cvtpk(yf[0], yf[1]); ow.y = cvtpk(yf[2], yf[3]); ow.z = cvtpk(yf[4], yf[5]); ow.w = cvtpk(yf[6], yf[7]);
            *(u32x4*)(cf.OUT + (row_base + row) * cf.ldo + cf.ocol + hh * 128 + cg * 8) = ow; }
    }
    __syncthreads();
}
}

#define XB_TMO      128
#define XB_XCNT(j)  (256  + 64 * (j))
#define XB_XSUB(j)  (1280 + 64 * (j))
#define XB_XGEN(j)  (2304 + 64 * (j))
#define XB_TOP      3328
#define XB_TOPGEN   3392
#define XCD_BAR_WORDS 3456
#define XB_SPIN_CAP (1u << 18)
__device__ __forceinline__ unsigned xb_ld(unsigned* p)              { return __hip_atomic_load(p, __ATOMIC_RELAXED, __HIP_MEMORY_SCOPE_AGENT); }
__device__ __forceinline__ unsigned xb_add(unsigned* p, unsigned v) { return __hip_atomic_fetch_add(p, v, __ATOMIC_RELAXED, __HIP_MEMORY_SCOPE_AGENT); }
__device__ __forceinline__ unsigned xb_xcc_id() { return (unsigned)__builtin_amdgcn_s_getreg((3 << 11) | 20) & 0xFu; }
#define XB_SPIN(cond, bar) do { unsigned _sp = 0; while (cond) { __builtin_amdgcn_s_sleep(1); \
    if ((++_sp & 255u) == 0u) { if (xb_ld(&(bar)[XB_TMO])) break; if (_sp > XB_SPIN_CAP) { atomicAdd(&(bar)[XB_TMO], 1u); break; } } } } while (0)
struct XcdBarrier { unsigned* bar; unsigned x; volatile LAS unsigned* st; };
__device__ __forceinline__ XcdBarrier xcd_barrier_post(unsigned* bar, volatile LAS unsigned* st, int WV_) {
    XcdBarrier b; b.bar = bar; b.x = xb_xcc_id(); b.st = st;
    if (otid() == 0) (void)xb_add(&bar[XB_XCNT(b.x)], 1u);
    return b;
}
__device__ __forceinline__ void xcd_barrier_complete(unsigned* bar, unsigned x, unsigned& nloc, unsigned& nx) {
    const unsigned G = gridDim.x * gridDim.y * gridDim.z;
    unsigned sum, cnt, mine, sp = 0u;
    for (;;) {
        sum = 0u; cnt = 0u; mine = 0u;
#pragma unroll
        for (unsigned j = 0; j < 16; ++j) { const unsigned c = xb_ld(&bar[XB_XCNT(j)]); sum += c; cnt += (c > 0u) ? 1u : 0u; mine = (j == x) ? c : mine; }
        if (sum == G) break;
        __builtin_amdgcn_s_sleep(1);
        if ((++sp & 255u) == 0u) { if (xb_ld(&bar[XB_TMO])) break; if (sp > XB_SPIN_CAP) { atomicAdd(&bar[XB_TMO], 1u); break; } }
    }
    nloc = mine > 0u ? mine : 1u; nx = cnt > 0u ? cnt : 1u;
}
__device__ __forceinline__ void xcd_barrier(const XcdBarrier& b, int WV_) {
    asm volatile("s_waitcnt vmcnt(0)" ::: "memory");
    __syncthreads();
    if (otid() == 0) {
        unsigned* bar = b.bar;
        __builtin_amdgcn_s_waitcnt(0);
        unsigned nloc = b.st[0], nx = b.st[1];
        if (nloc == 0u) { xcd_barrier_complete(bar, b.x, nloc, nx); b.st[0] = nloc; b.st[1] = nx; }
        const unsigned old = xb_add(&bar[XB_XSUB(b.x)], 1u);
        const unsigned gen = old / nloc;
        if (old + 1u == (gen + 1u) * nloc) {
            __builtin_amdgcn_fence(__ATOMIC_RELEASE, "agent");
            asm volatile("s_waitcnt vmcnt(0)" ::: "memory");
            const unsigned og = xb_add(&bar[XB_TOP], 1u);
            const unsigned tg = og / nx;
            if (og + 1u == (tg + 1u) * nx) xb_add(&bar[XB_TOPGEN], 1u);
            else XB_SPIN(xb_ld(&bar[XB_TOPGEN]) == tg, bar);
            __builtin_amdgcn_fence(__ATOMIC_ACQUIRE, "agent");
            xb_add(&bar[XB_XGEN(b.x)], 1u);
            asm volatile("s_waitcnt vmcnt(0)" ::: "memory");
        } else {
            XB_SPIN(xb_ld(&bar[XB_XGEN(b.x)]) == gen, bar);
            __builtin_amdgcn_fence(__ATOMIC_ACQUIRE, "agent");
            asm volatile("s_waitcnt vmcnt(0)" ::: "memory");
        }
    }
    __syncthreads();
}

constexpr int NWAVES = 8;
constexpr int RING_BYTES = 131072, MISC_OFF = RING_BYTES + 320, LDS_BYTES = 147456;

struct Args { const float* in[32]; float* out; unsigned char* ws; int ph_lo, ph_hi; };
#define CAS __attribute__((address_space(4)))
#define KWS(A) ((unsigned char*)(((void* const volatile CAS*)__builtin_amdgcn_kernarg_segment_ptr())[33]))
#define KOUT(A) ((float*)(((void* const volatile CAS*)__builtin_amdgcn_kernarg_segment_ptr())[32]))
#define KARG(A, i) (((const float* const volatile CAS*)__builtin_amdgcn_kernarg_segment_ptr())[i])

template <class RowMap>
__device__ __forceinline__ void tr_item(const float* W, int ldw, int k0, int n0, bf16_t* WT, int ldk, const RowMap& rm, LAS float* scr, int lane, const float* gain = nullptr) {
    float tv[32];
#pragma unroll
    for (int i = 0; i < 32; ++i) { const int kk = 2 * i + (lane >> 5); tv[i] = __builtin_nontemporal_load(&W[(size_t)(k0 + kk) * ldw + n0 + (lane & 31)]); }
#pragma unroll
    for (int i = 0; i < 32; ++i) { const int kk = 2 * i + (lane >> 5); scr[kk * 33 + (lane & 31)] = tv[i]; }
    LDS_WAIT(); asm volatile("" ::: "memory");
    const int c = lane & 7;
    float gk[8];
#pragma unroll
    for (int e = 0; e < 8; ++e) gk[e] = gain ? gain[k0 + 8 * c + e] : 1.f;
#pragma unroll
    for (int j = 0; j < 4; ++j) { const int n = (lane >> 3) + 8 * j; const LAS float* s = scr + (8 * c) * 33 + n;
        u32x4 o; o.x = cvtpk(s[0 * 33] * gk[0], s[1 * 33] * gk[1]); o.y = cvtpk(s[2 * 33] * gk[2], s[3 * 33] * gk[3]); o.z = cvtpk(s[4 * 33] * gk[4], s[5 * 33] * gk[5]); o.w = cvtpk(s[6 * 33] * gk[6], s[7 * 33] * gk[7]);
        *(u32x4*)(WT + (size_t)rm(n0 + n) * ldk + k0 + 8 * c) = o; }
    LDS_WAIT(); asm volatile("" ::: "memory");
}
struct RmId { __device__ int operator()(int n) const { return n; } };
struct RmUq { __device__ int operator()(int n) const { const int h = n / 96, j = n % 96; if (j < 64) return h * 128 + j; const int i = j - 64; return h * 128 + 64 + ((i < 16) ? 2 * i : 2 * (i - 16) + 1); } };
struct RmUkv { __device__ int operator()(int n) const { const int h = n / 192, j = n % 192; return j < 64 ? h * 128 + j : 512 + h * 128 + (j - 64); } };
struct RmGU { int up; __device__ int operator()(int n) const { return (n >> 7) * 256 + up * 128 + (n & 127); } };

__device__ __forceinline__ void moe_weight_item(const Args& a, int layer, int r, LAS float* scr, int lane) {
    const int e = r / 768, q = r % 768;
    bf16_t* WGU = (bf16_t*)(KWS(a) + WS_WGU) + (size_t)e * 1024 * 1024; bf16_t* WDN = (bf16_t*)(KWS(a) + WS_WDN) + (size_t)e * 1024 * 512;
    const size_t eo = ((size_t)layer * 32 + e) * (size_t)(1024 * 512);
    if (q < 256) { tr_item(KARG(a, 29) + eo, 512, 64 * (q / 16), 32 * (q % 16), WGU, 1024, RmGU{0}, scr, lane); }
    else if (q < 512) { const int qq = q - 256; tr_item(KARG(a, 30) + eo, 512, 64 * (qq / 16), 32 * (qq % 16), WGU, 1024, RmGU{1}, scr, lane); }
    else { const int qq = q - 512; tr_item(KARG(a, 31) + eo, 1024, 64 * (qq / 32), 32 * (qq % 32), WDN, 512, RmId{}, scr, lane); }
}

__device__ __forceinline__ void p_prologue(const Args& a, char* lds, int vcu, int G, int WV_) {
    const int tid = otid(), lane = tid & 63, wave = tid >> 6;
    LAS float* scr = (LAS float*)((LAS char*)lds + wave * 16384);
    const int gw = vcu * NWAVES + wave, NGW = G * NWAVES;
    bf16_t* WIN0 = (bf16_t*)(KWS(a) + WS_WIN0); bf16_t* WOUT0 = (bf16_t*)(KWS(a) + WS_WOUT0); bf16_t* WIN1 = (bf16_t*)(KWS(a) + WS_WIN1); bf16_t* WOUT1 = (bf16_t*)(KWS(a) + WS_WOUT1);
    bf16_t* WUQ = (bf16_t*)(KWS(a) + WS_WUQ); bf16_t* WUKV = (bf16_t*)(KWS(a) + WS_WUKV);
    constexpr int I_IN0 = 16 * 112, I_OUT = 16 * 32, I_IN1 = 16 * 62, I_UQ = 4 * 12, I_UKV = 2 * 24, I_MOE = 32 * 768;
    constexpr int NITEMS = I_IN0 + 2 * I_OUT + I_IN1 + I_UQ + I_UKV + I_MOE;
    for (int it = gw; it < NITEMS; it += NGW) {
        int r = it;
        if (r < I_MOE) { moe_weight_item(a, 0, r, scr, lane); continue; } r -= I_MOE;
        if (r < I_IN0) { tr_item(KARG(a, 1), 3584, 64 * (r / 112), 32 * (r % 112), WIN0, 1024, RmId{}, scr, lane); continue; } r -= I_IN0;
        if (r < I_OUT) { tr_item(KARG(a, 9), 1024, 64 * (r / 32), 32 * (r % 32), WOUT0, 1024, RmId{}, scr, lane); continue; } r -= I_OUT;
        if (r < I_IN1) { tr_item(KARG(a, 10), 1984, 64 * (r / 62), 32 * (r % 62), WIN1, 1024, RmId{}, scr, lane); continue; } r -= I_IN1;
        if (r < I_OUT) { tr_item(KARG(a, 20), 1024, 64 * (r / 32), 32 * (r % 32), WOUT1, 1024, RmId{}, scr, lane); continue; } r -= I_OUT;
        if (r < I_UQ) { tr_item(KARG(a, 12), 384, 64 * (r / 12), 32 * (r % 12), WUQ, 256, RmUq{}, scr, lane, KARG(a, 11)); continue; } r -= I_UQ;
        tr_item(KARG(a, 14), 768, 64 * (r / 24), 32 * (r % 24), WUKV, 256, RmUkv{}, scr, lane, KARG(a, 13));
    }
    const int gt = vcu * 512 + tid, NT = G * 512;
    const u32x4 z4 = {0u, 0u, 0u, 0u};
    for (int i = gt; i < 64 * 128; i += NT) *(u32x4*)(WIN1 + (size_t)1984 * 1024 + (size_t)i * 8) = z4;
    for (int i = gt; i < 128 * 32; i += NT) { const int rr = i / 32, c8 = i % 32; *(u32x4*)(WUQ + (size_t)((rr / 32) * 128 + 96 + (rr % 32)) * 256 + c8 * 8) = z4; }
    for (int i = gt; i < 256 * 16; i += NT) { const int rr = i / 16, c8 = i % 16; *(u32x4*)(WUKV + (size_t)((rr / 64) * 128 + 64 + (rr % 64)) * 256 + c8 * 8) = z4; }
    for (int i = gt; i < 1024 * 16; i += NT) { const int rr = i / 16, c8 = i % 16; *(u32x4*)(WUKV + (size_t)rr * 256 + 128 + c8 * 8) = z4; }
    float* WR = (float*)(KWS(a) + WS_WR);
    for (int i = gt; i < 2 * 36 * 1024; i += NT) { const int l = i / (36 * 1024), j = (i / 1024) % 36, k = i % 1024;
        WR[i] = j < 4 ? KARG(a, 25)[((size_t)l * 1024 + k) * 4 + j] : KARG(a, 27)[((size_t)l * 1024 + k) * 32 + (j - 4)]; }
    float* TAB = (float*)(KWS(a) + WS_TAB);
    { const int P = NT / 88;
      if (gt < 88 * P) { const int q = gt % 88, p0 = gt / 88;
        double inv; float* tc; float* tsn; int stride, f;
        if (q < 64) { f = q; inv = pow(10000.0, -(double)q / 64.0); tc = TAB + TAB_COSR; tsn = TAB + TAB_SINR; stride = 64; }
        else if (q < 72) { f = q - 64; inv = pow(500000.0, -(double)f / 8.0); tc = TAB + TAB_COSD; tsn = TAB + TAB_SIND; stride = 8; }
        else { f = q - 72; inv = pow(500000.0, -(double)f / 16.0); tc = TAB + TAB_COSM; tsn = TAB + TAB_SINM; stride = 16; }
        for (int pos = p0; pos < SEQ; pos += P) { double sv, cv; sincos((double)pos * inv, &sv, &cv); tc[(size_t)pos * stride + f] = (float)cv; tsn[(size_t)pos * stride + f] = (float)sv; } } }
    bf16_t* XB = (bf16_t*)(KWS(a) + WS_XB); const float* x = KARG(a, 0);
    for (size_t i = gt; i < (size_t)NTOK * DM / 8; i += NT) { const f32x4 v0 = __builtin_nontemporal_load((const f32x4*)(x + i * 8)), v1 = __builtin_nontemporal_load((const f32x4*)(x + i * 8 + 4));
        u32x4 o; o.x = cvtpk(v0[0], v0[1]); o.y = cvtpk(v0[2], v0[3]); o.z = cvtpk(v1[0], v1[1]); o.w = cvtpk(v1[2], v1[3]); *(u32x4*)(XB + i * 8) = o; }
}

__device__ __forceinline__ void rot8(u32x4& w1, u32x4& w2, const float* cs, const float* sn, float scale) {
    const f32x4 c0 = *(const f32x4*)cs, c1 = *(const f32x4*)(cs + 4), s0 = *(const f32x4*)sn, s1 = *(const f32x4*)(sn + 4);
    float a[8] = {bflo(w1.x), bfhi(w1.x), bflo(w1.y), bfhi(w1.y), bflo(w1.z), bfhi(w1.z), bflo(w1.w), bfhi(w1.w)};
    float b[8] = {bflo(w2.x), bfhi(w2.x), bflo(w2.y), bfhi(w2.y), bflo(w2.z), bfhi(w2.z), bflo(w2.w), bfhi(w2.w)};
    float cc[8] = {c0[0], c0[1], c0[2], c0[3], c1[0], c1[1], c1[2], c1[3]}, ss[8] = {s0[0], s0[1], s0[2], s0[3], s1[0], s1[1], s1[2], s1[3]};
    float ra[8], rb[8];
#pragma unroll
    for (int j = 0; j < 8; ++j) { ra[j] = (a[j] * cc[j] - b[j] * ss[j]) * scale; rb[j] = (b[j] * cc[j] + a[j] * ss[j]) * scale; }
    w1.x = cvtpk(ra[0], ra[1]); w1.y = cvtpk(ra[2], ra[3]); w1.z = cvtpk(ra[4], ra[5]); w1.w = cvtpk(ra[6], ra[7]);
    w2.x = cvtpk(rb[0], rb[1]); w2.y = cvtpk(rb[2], rb[3]); w2.z = cvtpk(rb[4], rb[5]); w2.w = cvtpk(rb[6], rb[7]);
}

__device__ __forceinline__ void p_rot0(const Args& a, int vcu, int G, int WV_) {
    const int tid = otid(), lane = tid & 63, wave = tid >> 6, gw = vcu * NWAVES + wave, NGW = G * NWAVES;
    bf16_t* Z = (bf16_t*)(KWS(a) + WS_Z); const float* TAB = (const float*)(KWS(a) + WS_TAB);
    const int tq = lane >> 5, h = (lane >> 3) & 3, i8 = lane & 7;
    const int drow = lane >> 4, dtq = (lane >> 3) & 1, dblk = lane & 7;
    for (int g = gw; g < NTOK / 4; g += NGW) { const int row0 = g * 4;
        u32x4 w1[5], w2[5]; bf16_t* p1[5];
#pragma unroll
        for (int i = 0; i < 4; ++i) { p1[i] = Z + (size_t)(row0 + i) * LDZ0 + tq * 512 + h * 128 + i8 * 8; w1[i] = *(u32x4*)p1[i]; w2[i] = *(u32x4*)(p1[i] + 64); }
        p1[4] = Z + (size_t)(row0 + drow) * LDZ0 + Z0_DQ + dtq * 512 + dblk * 64; w1[4] = *(u32x4*)p1[4]; w2[4] = *(u32x4*)(p1[4] + 8);
#pragma unroll
        for (int i = 0; i < 4; ++i) { const int pos = (row0 + i) & (SEQ - 1);
            rot8(w1[i], w2[i], TAB + TAB_COSR + (size_t)pos * 64 + i8 * 8, TAB + TAB_SINR + (size_t)pos * 64 + i8 * 8, tq ? 0.08838834764831845f : 1.f); }
        { const int pos = (row0 + drow) & (SEQ - 1); rot8(w1[4], w2[4], TAB + TAB_COSD + (size_t)pos * 8, TAB + TAB_SIND + (size_t)pos * 8, 1.f); }
#pragma unroll
        for (int i = 0; i < 4; ++i) { *(u32x4*)p1[i] = w1[i]; *(u32x4*)(p1[i] + 64) = w2[i]; }
        *(u32x4*)p1[4] = w1[4]; *(u32x4*)(p1[4] + 8) = w2[4];
    }
}

__device__ __forceinline__ void p_diffcomb(const Args& a, int vcu, int G, int WV_) {
    const int tid = otid(), lane = tid & 63, wave = tid >> 6, gw = vcu * NWAVES + wave, NGW = G * NWAVES;
    float s1 = KARG(a, 4)[lane] * KARG(a, 5)[lane], s2 = KARG(a, 6)[lane] * KARG(a, 7)[lane];
    s1 = wave_sum(s1); s2 = wave_sum(s2);
    const float lam_init = 0.2f;
    const float lam = (expf(s1) - expf(s2)) + lam_init;
    const float* OA = (const float*)(KWS(a) + WS_OAB); const float* OB = OA + (size_t)NTOK * 512; bf16_t* A2 = (bf16_t*)(KWS(a) + WS_A2);
    const float g0 = KARG(a, 8)[lane * 2], g1 = KARG(a, 8)[lane * 2 + 1];
    for (int t = gw; t < NTOK * 4; t += NGW) { const int row = t >> 2, h = t & 3; const size_t off = (size_t)row * 512 + h * 128 + lane * 2;
        const f32x2 va = *(const f32x2*)(OA + off), vb = *(const f32x2*)(OB + off);
        const float o0 = va[0] - lam * vb[0], o1 = va[1] - lam * vb[1];
        const float ms = wave_sum(o0 * o0 + o1 * o1) * (1.f / 128.f);
        const float rs = (1.f / sqrtf(ms + 1e-6f)) * (1.f - lam_init);
        *(unsigned*)(A2 + (size_t)row * 1024 + 512 + h * 128 + lane * 2) = cvtpk(o0 * rs * g0, o1 * rs * g1); }
}

__device__ __forceinline__ void unpack8(const u32x4 w, float* f) { f[0] = bflo(w.x); f[1] = bfhi(w.x); f[2] = bflo(w.y); f[3] = bfhi(w.y); f[4] = bflo(w.z); f[5] = bfhi(w.z); f[6] = bflo(w.w); f[7] = bfhi(w.w); }
__device__ __forceinline__ u32x4 pack8(const float* f) { u32x4 w; w.x = cvtpk(f[0], f[1]); w.y = cvtpk(f[2], f[3]); w.z = cvtpk(f[4], f[5]); w.w = cvtpk(f[6], f[7]); return w; }
__device__ __forceinline__ void ln_row16(float* v, const float* gv, const float* bv) {
    float s = 0.f;
#pragma unroll
    for (int i = 0; i < 16; ++i) s += v[i];
    const float mean = wave_sum(s) * (1.f / 1024.f); float q = 0.f;
#pragma unroll
    for (int i = 0; i < 16; ++i) { v[i] -= mean; q += v[i] * v[i]; }
    const float rstd = 1.f / sqrtf(wave_sum(q) * (1.f / 1024.f) + LN_EPS);
#pragma unroll
    for (int i = 0; i < 16; ++i) v[i] = v[i] * rstd * gv[i] + bv[i];
}
template <bool XF32>
__device__ __forceinline__ void p_ln1_router(const Args& a, char* lds, int vcu, int G, int layer, const void* xprev, int WV_) {
    const int tid = otid(), lane = tid & 63, wave = tid >> 6, gw = vcu * NWAVES + wave, NGW = G * NWAVES;
    const bf16_t* Yb = (const bf16_t*)(KWS(a) + WS_Y); bf16_t* XBp = (bf16_t*)(KWS(a) + WS_XB);
    const float* gam = KARG(a, 21) + layer * 1024; const float* bet = KARG(a, 22) + layer * 1024;
    const float* WR = (const float*)(KWS(a) + WS_WR) + (size_t)layer * 36 * 1024;
    unsigned* cnt = (unsigned*)(KWS(a) + WS_CNTB);
    int4* asg = (int4*)(KWS(a) + WS_ASG);
    LAS float* lg = (LAS float*)((LAS char*)lds + wave * 2048);
    LAS unsigned* lcnt = (LAS unsigned*)((LAS char*)lds + 16384);
    if (tid < 32) lcnt[tid] = 0u;
    __syncthreads();
    float gv[16], bv[16];
#pragma unroll
    for (int j = 0; j < 2; ++j)
#pragma unroll
        for (int q = 0; q < 2; ++q) { const f32x4 g4 = *(const f32x4*)(gam + 8 * lane + 512 * j + 4 * q), b4 = *(const f32x4*)(bet + 8 * lane + 512 * j + 4 * q);
#pragma unroll
            for (int e = 0; e < 4; ++e) { gv[j * 8 + q * 4 + e] = g4[e]; bv[j * 8 + q * 4 + e] = b4[e]; } }
    const int rbit = 4 * (lane & 1) + 2 * ((lane >> 1) & 1) + ((lane >> 2) & 1);
    for (int g8 = gw; g8 < NTOK / 8; g8 += NGW) {
        float xn[8][16];
#pragma unroll
        for (int half = 0; half < 2; ++half) {
            u32x4 yb[4][2];
#pragma unroll
            for (int r4 = 0; r4 < 4; ++r4) { const int rr = half * 4 + r4; const size_t ro = (size_t)(g8 * 8 + rr) * 1024 + 8 * lane;
#pragma unroll
                for (int j = 0; j < 2; ++j) {
                    if constexpr (XF32) { const f32x4 x0 = *(const f32x4*)((const float*)xprev + ro + 512 * j), x1 = *(const f32x4*)((const float*)xprev + ro + 512 * j + 4);
#pragma unroll
                        for (int e = 0; e < 4; ++e) { xn[rr][j * 8 + e] = x0[e]; xn[rr][j * 8 + 4 + e] = x1[e]; } }
                    else { const u32x4 xw = *(const u32x4*)((const bf16_t*)xprev + ro + 512 * j); unpack8(xw, &xn[rr][j * 8]); }
                    yb[r4][j] = __builtin_nontemporal_load((const u32x4*)(Yb + ro + 512 * j)); } }
#pragma unroll
            for (int r4 = 0; r4 < 4; ++r4) { const int rr = half * 4 + r4; const size_t ro = (size_t)(g8 * 8 + rr) * 1024 + 8 * lane;
#pragma unroll
                for (int j = 0; j < 2; ++j) { float yf[8]; unpack8(yb[r4][j], yf);
#pragma unroll
                    for (int e = 0; e < 8; ++e) xn[rr][j * 8 + e] = xn[rr][j * 8 + e] * ALPHA + yf[e]; }
                ln_row16(xn[rr], gv, bv);
#pragma unroll
                for (int j = 0; j < 2; ++j) *(u32x4*)(XBp + ro + 512 * j) = pack8(&xn[rr][j * 8]); }
        }
#define RT_LOAD(W, J) do { _Pragma("unroll") for (int j = 0; j < 4; ++j) W[j] = *(const f32x4*)(WR + (size_t)(J) * 1024 + 8 * lane + 512 * (j >> 1) + 4 * (j & 1)); } while (0)
#define RT_STEP(W, J) do { float ps[8]; \
            _Pragma("unroll") for (int rr = 0; rr < 8; ++rr) { float s = 0.f; \
                _Pragma("unroll") for (int j = 0; j < 4; ++j) _Pragma("unroll") for (int e = 0; e < 4; ++e) s = fmaf(xn[rr][j * 4 + e], W[j][e], s); \
                ps[rr] = s; } \
            float n1[4], n2[2]; \
            _Pragma("unroll") for (int i = 0; i < 4; ++i) { const float send = b0 ? ps[i] : ps[i + 4], keep = b0 ? ps[i + 4] : ps[i]; n1[i] = keep + __shfl_xor(send, 1); } \
            _Pragma("unroll") for (int i = 0; i < 2; ++i) { const float send = b1 ? n1[i] : n1[i + 2], keep = b1 ? n1[i + 2] : n1[i]; n2[i] = keep + __shfl_xor(send, 2); } \
            float tot; { const float send = b2 ? n2[0] : n2[1], keep = b2 ? n2[1] : n2[0]; tot = keep + __shfl_xor(send, 4); } \
            tot += __shfl_xor(tot, 8); tot += __shfl_xor(tot, 16); tot += __shfl_xor(tot, 32); \
            if (lane < 8) lg[rbit * 40 + (J)] = tot; } while (0)
        { const bool b0 = lane & 1, b1 = lane & 2, b2 = lane & 4;
          f32x4 wvA[4], wvB[4];
          RT_LOAD(wvA, 0);
          for (int jo = 0; jo < 36; jo += 2) {
              RT_LOAD(wvB, jo + 1);
              RT_STEP(wvA, jo);
              if (jo + 2 < 36) RT_LOAD(wvA, jo + 2);
              RT_STEP(wvB, jo + 1); } }
#undef RT_LOAD
#undef RT_STEP
        LDS_WAIT(); asm volatile("" ::: "memory");
        if (lane < 8) { const int row = g8 * 8 + lane; const LAS float* l = lg + lane * 40;
            float gl[4]; int gi = 0;
#pragma unroll
            for (int j = 0; j < 4; ++j) gl[j] = l[j] + KARG(a, 26)[layer * 4 + j];
            float gm = gl[0];
#pragma unroll
            for (int j = 1; j < 4; ++j) if (gl[j] > gm) { gm = gl[j]; gi = j; }
            float den = 0.f;
#pragma unroll
            for (int j = 0; j < 4; ++j) den += expf(gl[j] - gm);
            const float pg = 1.f / den;
            float l1 = -3.0e38f, l2 = -3.0e38f; int i1 = 0, i2 = 0;
            for (int j = 0; j < 8; ++j) { const float v = l[4 + gi * 8 + j] + KARG(a, 28)[layer * 32 + gi * 8 + j];
                if (v > l1) { l2 = l1; i2 = i1; l1 = v; i1 = j; } else if (v > l2) { l2 = v; i2 = j; } }
            const float e2 = expf(l2 - l1), w1 = 1.f / (1.f + e2), w2 = e2 * w1;
            const int e1i = gi * 8 + i1, e2i = gi * 8 + i2;
            const unsigned sl1 = __hip_atomic_fetch_add(lcnt + e1i, 1u, __ATOMIC_RELAXED, __HIP_MEMORY_SCOPE_WORKGROUP), sl2 = __hip_atomic_fetch_add(lcnt + e2i, 1u, __ATOMIC_RELAXED, __HIP_MEMORY_SCOPE_WORKGROUP);
            asg[row * 2 + 0] = make_int4(e1i, (int)sl1, __float_as_int(pg * w1), (int)blockIdx.x);
            asg[row * 2 + 1] = make_int4(e2i, (int)sl2, __float_as_int(pg * w2), (int)blockIdx.x); }
        LDS_WAIT(); asm volatile("" ::: "memory");
    }
    __syncthreads();
    if (tid < 32) cnt[(size_t)blockIdx.x * 32 + tid] = lcnt[tid];
}

__device__ __forceinline__ void p_moe_scatter(const Args& a, char* lds, int vcu, int G, int layer, int WV_) {
    const int tid = otid(), lane = tid & 63, wave = tid >> 6, gw = vcu * NWAVES + wave, NGW = G * NWAVES;
    const unsigned* cntb = (const unsigned*)(KWS(a) + WS_CNTB);
    LAS int* off = (LAS int*)((LAS char*)lds);
    LAS unsigned short* pb = (LAS unsigned short*)((LAS char*)lds + 1024);
    {
        const int e = tid >> 4, s = tid & 15; unsigned c[16]; unsigned run = 0;
#pragma unroll
        for (int i = 0; i < 16; ++i) { const int b = s * 16 + i; c[i] = (b < G) ? cntb[(size_t)b * 32 + e] : 0u; }
        LAS unsigned* seg = (LAS unsigned*)((LAS char*)lds + 20480);
#pragma unroll
        for (int i = 0; i < 16; ++i) run += c[i];
        seg[e * 16 + s] = run;
        __syncthreads();
        unsigned base = 0; for (int q = 0; q < s; ++q) base += seg[e * 16 + q];
#pragma unroll
        for (int i = 0; i < 16; ++i) { const int b = s * 16 + i; if (b < G) pb[b * 32 + e] = (unsigned short)base; base += c[i]; }
        if (s == 15) off[40 + e] = (int)base;
        __syncthreads();
        if (tid == 0) { int o = 0; for (int q = 0; q < 32; ++q) { off[q] = o; o += (off[40 + q] + 255) & ~255; } off[32] = o; }
        __syncthreads();
    }
    const int4* asg = (const int4*)(KWS(a) + WS_ASG); int2* rowinfo = (int2*)(KWS(a) + WS_ROWINFO); int* tiles = (int*)(KWS(a) + WS_TILES);
    for (int as = vcu * 512 + tid; as < NTOK * 2; as += G * 512) { const int4 q = asg[as]; const int dest = off[q.x] + (int)pb[q.w * 32 + q.x] + q.y; rowinfo[dest] = make_int2(as, q.z); }
    if (blockIdx.x < 32) { const int e = blockIdx.x; const int c = off[40 + e];
        for (int r = off[e] + c + tid; r < off[e + 1]; r += 512) rowinfo[r] = make_int2(-1, 0); }
    if (blockIdx.x == 32 && tid < 64) { const int nt = off[32] >> 8; if (tid == 0) tiles[0] = nt;
        for (int t = tid; t < nt; t += 64) { int e = 0; for (int jj = 1; jj < 32; ++jj) if (off[jj] <= t * 256) e = jj; tiles[1 + t] = e; } }
    __syncthreads();
}

template <bool FINAL>
__device__ __forceinline__ void p_ln2(const Args& a, int vcu, int G, int layer, float* xout, int WV_) {
    const int tid = otid(), lane = tid & 63, wave = tid >> 6, gw = vcu * NWAVES + wave, NGW = G * NWAVES;
    const bf16_t* YS = (const bf16_t*)(KWS(a) + WS_YS); bf16_t* XBp = (bf16_t*)(KWS(a) + WS_XB);
    const float* gam = KARG(a, 23) + layer * 1024; const float* bet = KARG(a, 24) + layer * 1024;
    float gv[16], bv[16];
#pragma unroll
    for (int j = 0; j < 2; ++j)
#pragma unroll
        for (int q = 0; q < 2; ++q) { const f32x4 g4 = *(const f32x4*)(gam + 8 * lane + 512 * j + 4 * q), b4 = *(const f32x4*)(bet + 8 * lane + 512 * j + 4 * q);
#pragma unroll
            for (int e = 0; e < 4; ++e) { gv[j * 8 + q * 4 + e] = g4[e]; bv[j * 8 + q * 4 + e] = b4[e]; } }
    for (int g8 = gw; g8 < NTOK / 4; g8 += NGW) {
        u32x4 xw[4][2], y0[4][2], y1[4][2];
#pragma unroll
        for (int rr = 0; rr < 4; ++rr) { const size_t ro = (size_t)(g8 * 4 + rr) * 1024 + 8 * lane;
#pragma unroll
            for (int j = 0; j < 2; ++j) { xw[rr][j] = *(const u32x4*)(XBp + ro + 512 * j); y0[rr][j] = __builtin_nontemporal_load((const u32x4*)(YS + ro + 512 * j)); y1[rr][j] = __builtin_nontemporal_load((const u32x4*)(YS + (size_t)NTOK * 1024 + ro + 512 * j)); } }
#pragma unroll
        for (int rr = 0; rr < 4; ++rr) { const size_t ro = (size_t)(g8 * 4 + rr) * 1024 + 8 * lane; float v[16];
#pragma unroll
            for (int j = 0; j < 2; ++j) { float xf[8], a0[8], a1[8]; unpack8(xw[rr][j], xf); unpack8(y0[rr][j], a0); unpack8(y1[rr][j], a1);
#pragma unroll
                for (int e = 0; e < 8; ++e) v[j * 8 + e] = xf[e] * ALPHA + (a0[e] + a1[e]); }
            ln_row16(v, gv, bv);
#pragma unroll
            for (int j = 0; j < 2; ++j) {
                if constexpr (FINAL) { __builtin_nontemporal_store((f32x4){v[j * 8], v[j * 8 + 1], v[j * 8 + 2], v[j * 8 + 3]}, (f32x4*)(xout + ro + 512 * j)); __builtin_nontemporal_store((f32x4){v[j * 8 + 4], v[j * 8 + 5], v[j * 8 + 6], v[j * 8 + 7]}, (f32x4*)(xout + ro + 512 * j + 4)); }
                else *(u32x4*)(XBp + ro + 512 * j) = pack8(&v[j * 8]); } }
    }
}

__device__ __forceinline__ void p_front1(const Args& a, int vcu, int G, int WV_) {
    const int tid = otid(), lane = tid & 63, wave = tid >> 6, gw = vcu * NWAVES + wave, NGW = G * NWAVES;
    const bf16_t* Z = (const bf16_t*)(KWS(a) + WS_Z); bf16_t* MK = (bf16_t*)(KWS(a) + WS_MK); const float* TAB = (const float*)(KWS(a) + WS_TAB);
    for (int g = gw; g * 32 < NTOK; g += NGW) { const int row = g * 32 + (lane >> 1), i8 = lane & 1, pos = row & (SEQ - 1);
        const bf16_t* p1 = Z + (size_t)row * LDZ1 + Z1_KR + i8 * 8;
        u32x4 w1 = *(const u32x4*)p1, w2 = *(const u32x4*)(p1 + 16);
        rot8(w1, w2, TAB + TAB_COSM + (size_t)pos * 16 + i8 * 8, TAB + TAB_SINM + (size_t)pos * 16 + i8 * 8, 1.f);
        u32x4 lo, hi2;
        lo.x = (w1.x & 0xffffu) | (w2.x << 16); lo.y = (w1.x >> 16) | (w2.x & 0xffff0000u); lo.z = (w1.y & 0xffffu) | (w2.y << 16); lo.w = (w1.y >> 16) | (w2.y & 0xffff0000u);
        hi2.x = (w1.z & 0xffffu) | (w2.z << 16); hi2.y = (w1.z >> 16) | (w2.z & 0xffff0000u); hi2.z = (w1.w & 0xffffu) | (w2.w << 16); hi2.w = (w1.w >> 16) | (w2.w & 0xffff0000u);
#pragma unroll
        for (int h = 0; h < 4; ++h) { bf16_t* d = MK + (size_t)row * 512 + h * 128 + 64 + 16 * i8; *(u32x4*)d = lo; *(u32x4*)(d + 8) = hi2; } }
    float* BF = (float*)(KWS(a) + WS_BF); float* BB = (float*)(KWS(a) + WS_BB);
    const int dir = tid >> 8, j = tid & 255;
    const float* w2p = dir ? KARG(a, 17) : KARG(a, 15); const float bias = (dir ? KARG(a, 18) : KARG(a, 16))[j];
    float wv[16];
#pragma unroll
    for (int i = 0; i < 16; ++i) wv[i] = w2p[i * 256 + j];
    float* Bo = dir ? BB : BF;
    const bool split = (G == 256); const int u0 = split ? (int)blockIdx.x - 128 : vcu, ustep = split ? 128 : G;
    for (int u = u0; u >= 0 && u < 256; u += ustep) { const long rb = (long)(u >> 7) * SEQ + (long)(u & 127) * 64; float run = 0.f;
        for (int s0 = 0; s0 < 64; s0 += 8) { u32x4 l0[8], l1[8];
#pragma unroll
            for (int i = 0; i < 8; ++i) { const long row = rb + (dir ? 63 - (s0 + i) : (s0 + i)); l0[i] = *(const u32x4*)(Z + (size_t)row * LDZ1 + Z1_LRF + dir * 16); l1[i] = *(const u32x4*)(Z + (size_t)row * LDZ1 + Z1_LRF + dir * 16 + 8); }
#pragma unroll
            for (int i = 0; i < 8; ++i) { const long row = rb + (dir ? 63 - (s0 + i) : (s0 + i));
                float z = bias;
                z += bflo(l0[i].x) * wv[0] + bfhi(l0[i].x) * wv[1] + bflo(l0[i].y) * wv[2] + bfhi(l0[i].y) * wv[3] + bflo(l0[i].z) * wv[4] + bfhi(l0[i].z) * wv[5] + bflo(l0[i].w) * wv[6] + bfhi(l0[i].w) * wv[7];
                z += bflo(l1[i].x) * wv[8] + bfhi(l1[i].x) * wv[9] + bflo(l1[i].y) * wv[10] + bfhi(l1[i].y) * wv[11] + bflo(l1[i].z) * wv[12] + bfhi(l1[i].z) * wv[13] + bflo(l1[i].w) * wv[14] + bfhi(l1[i].w) * wv[15];
                const float ls = fminf(z, 0.f) - __logf(1.f + __expf(-fabsf(z)));
                run += ls * (1.f / 16.f);
                Bo[(size_t)row * 256 + j] = run; } } }
}

constexpr int NPHASE = 28;
__global__ void __launch_bounds__(NWAVES * 64, 2) mega_fwd(Args args) {
    extern __shared__ __attribute__((aligned(16))) unsigned char lds_raw[];
    char* lds = (char*)lds_raw; LAS unsigned char* ldsl = (LAS unsigned char*)lds_raw;
    const int WV_ = __builtin_amdgcn_readfirstlane((int)threadIdx.x >> 6);
    const int tid = otid();
    const int G = gridDim.x; const int bx = blockIdx.x; const int vcu = (G % 8 == 0) ? (bx % 8) * (G / 8) + bx / 8 : bx;
    volatile LAS unsigned* MISC = (volatile LAS unsigned*)(ldsl + MISC_OFF);
    for (int u = tid; u < (LDS_BYTES - RING_BYTES) / 4; u += NWAVES * 64) ((LAS unsigned*)(ldsl + RING_BYTES))[u] = 0u;
    __syncthreads();
#define ws KWS(args)
    unsigned* ctl = (unsigned*)(ws + WS_CTL);
    const int lo = args.ph_lo, hi = args.ph_hi;
    const bool use_bar = (hi - lo) > 1;
    XcdBarrier bar; bar.bar = ctl + CW_BAR; bar.x = 0; bar.st = nullptr;
    if (use_bar) bar = xcd_barrier_post(ctl + CW_BAR, MISC + 8, WV_);
#define IN(k) (lo <= (k) && (k) < hi)
#define SEAM(k) do { if (IN(k) && IN((k) + 1)) xcd_barrier(bar, WV_); } while (0)
#define XB ((bf16_t*)(ws + WS_XB))
#define ZBUF ((bf16_t*)(ws + WS_Z))
#define A2 ((bf16_t*)(ws + WS_A2))
#define X1F ((float*)(ws + WS_X1F))
#define Y ((float*)(ws + WS_Y))

    if (IN(0)) { p_prologue(args, lds, vcu, G, WV_); } SEAM(0);
    if (IN(1)) { pg8::Gemm g{XB, (const bf16_t*)(ws + WS_WIN0), 1024, 1024, 1024}; pg8::StaticOrder S; S.init(NTOK, LDZ0, G, bx);
        pg8::EpiBf16 E{ZBUF, LDZ0, 0, 0}; pg8::gemm_phase<pg8::EpiBf16, pg8::StaticOrder, true>(ldsl, g, S, E, WV_); } SEAM(1);
    if (IN(2)) { p_rot0(args, vcu, G, WV_); } SEAM(2);
    {
        chk::Cfg cf; cf.Z = ZBUF; cf.ld = LDZ0; cf.qcol = Z0_RQ; cf.kcol = Z0_RK; cf.vcol = Z0_RV; cf.gcol = Z0_RG; cf.BF = nullptr; cf.BB = nullptr;
        cf.dec_f = KARG(args, 2); cf.dec_b = KARG(args, 3); cf.qscale = 1.f; cf.U = (bf16_t*)(ws + WS_U); cf.OUT = A2; cf.ldo = 1024; cf.ocol = 0; cf.gain = nullptr;
        if (IN(3)) { for (int u = vcu; u < 256; u += G) chk::chunk_states<128, true>(cf, lds, u, WV_); } SEAM(3);
        if (IN(4)) { chk::chunk_scan<128, true>(cf, bx * 512 + tid); } SEAM(4);
        if (IN(5)) { for (int u = vcu; u < 256; u += G) chk::chunk_out<128, true>(cf, lds, u, WV_); } SEAM(5);
    }
    if (IN(6)) { float* OAB = (float*)(ws + WS_OAB);
        const int ln = tid & 63; float s1 = KARG(args, 4)[ln] * KARG(args, 5)[ln], s2 = KARG(args, 6)[ln] * KARG(args, 7)[ln]; s1 = wave_sum(s1); s2 = wave_sum(s2);
        const float lam = (expf(s1) - expf(s2)) + 0.2f;
        for (int u = vcu; u < 256; u += G) { const int bh = u >> 5, qb = u & 31, h = bh & 3, b = bh >> 2;
            const size_t r0 = (size_t)b * SEQ; const bf16_t* Qp = ZBUF + (r0 + qb * 256) * LDZ0 + Z0_DQ + h * 128; const bf16_t* Kp = ZBUF + r0 * LDZ0 + Z0_DK + h * 128; const bf16_t* Vp = ZBUF + r0 * LDZ0 + Z0_DV + h * 128;
            float* Op = OAB + (r0 + qb * 256) * 512 + h * 128;
            att::attn_dense_body<0, 4, float>(Qp, LDZ0, Kp, LDZ0, Vp, LDZ0, Op, 512, SEQ, 0.125f, lds, WV_);
            att::attn_dense_body<4, 8, bf16_t, true>(Qp, LDZ0, Kp, LDZ0, Vp, LDZ0, A2 + (r0 + qb * 256) * 1024 + 512 + h * 128, 1024, SEQ, 0.125f, lds, WV_, Op, 512, lam, KARG(args, 8)); } } SEAM(6);
    if (IN(8)) { pg8::Gemm g{A2, (const bf16_t*)(ws + WS_WOUT0), 1024, 1024, 1024}; pg8::StaticOrder S; S.init(NTOK, 1024, G, bx);
        pg8::EpiBf16 E{(bf16_t*)Y, 1024, 0, 0}; pg8::gemm_phase<pg8::EpiBf16, pg8::StaticOrder, true>(ldsl, g, S, E, WV_); } SEAM(8);
    if (IN(9)) { p_ln1_router<false>(args, lds, vcu, G, 0, XB, WV_); } SEAM(9);
    if (IN(10)) { p_moe_scatter(args, lds, vcu, G, 0, WV_); } SEAM(10);
    if (IN(11)) { pg8::Gemm g{XB, (const bf16_t*)(ws + WS_WGU), 1024, 1024, 1024}; pg8::MoeOrder S{(const int*)(ws + WS_TILES), G, vcu, 1024};
        pg8::EpiGU E{(bf16_t*)(ws + WS_H), 512}; pg8::gemm_phase<pg8::EpiGU, pg8::MoeOrder, true, true>(ldsl, g, S, E, WV_, (const int2*)(ws + WS_ROWINFO)); } SEAM(11);
    if (IN(12)) { pg8::Gemm g{(const bf16_t*)(ws + WS_H), (const bf16_t*)(ws + WS_WDN), 512, 512, 512}; pg8::MoeOrder S{(const int*)(ws + WS_TILES), G, vcu, 1024};
        pg8::EpiDown E{(bf16_t*)(ws + WS_YS), (const int2*)(ws + WS_ROWINFO)}; pg8::gemm_phase<pg8::EpiDown, pg8::MoeOrder, true>(ldsl, g, S, E, WV_); } SEAM(12);
    if (IN(13)) { p_ln2<false>(args, vcu, G, 0, nullptr, WV_);
        { const int lane = tid & 63, wave = tid >> 6; LAS float* scr = (LAS float*)((LAS char*)lds + wave * 16384);
          for (int it = vcu * NWAVES + wave; it < 32 * 768; it += G * NWAVES) moe_weight_item(args, 1, it, scr, lane); } } SEAM(13);
    if (IN(14)) { pg8::Gemm g{XB, (const bf16_t*)(ws + WS_WIN1), 1024, 1024, 1024}; pg8::StaticOrder S; S.init(NTOK, LDZ1, G, bx);
        pg8::EpiBf16 E{ZBUF, LDZ1, 0, 0}; pg8::gemm_phase<pg8::EpiBf16, pg8::StaticOrder, true>(ldsl, g, S, E, WV_); } SEAM(14);
    if (IN(15)) { p_front1(args, vcu, G, WV_);
        const float* TABp = (const float*)(ws + WS_TAB);
        { pg8::Gemm g{ZBUF + Z1_CQ, (const bf16_t*)(ws + WS_WUQ), LDZ1, 256, 256}; pg8::StaticOrder S; S.init(NTOK, 512, G, bx);
          pg8::EpiNormUp<0, true, false> E{(bf16_t*)(ws + WS_MQ), 512, 0, 0, nullptr, 0, TABp + TAB_COSM, TABp + TAB_SINM}; pg8::gemm_phase<pg8::EpiNormUp<0, true, false>, pg8::StaticOrder, true>(ldsl, g, S, E, WV_); }
        { pg8::Gemm g{ZBUF + Z1_CKV, (const bf16_t*)(ws + WS_WUKV), LDZ1, 256, 256}; pg8::StaticOrder S; S.init(NTOK, 1024, G, bx);
          pg8::EpiNormUp<128, false, true> E{(bf16_t*)(ws + WS_MK), 512, 512, (size_t)(WS_MV - WS_MK) / 2, ZBUF + Z1_CKV, LDZ1, nullptr, nullptr}; pg8::gemm_phase<pg8::EpiNormUp<128, false, true>, pg8::StaticOrder, true>(ldsl, g, S, E, WV_); }
    } SEAM(15);
    if (IN(18)) { const bf16_t* MQ = (const bf16_t*)(ws + WS_MQ); const bf16_t* MK = (const bf16_t*)(ws + WS_MK); const bf16_t* MV = (const bf16_t*)(ws + WS_MV);
        for (int u = vcu; u < 256; u += G) { const int bh = u >> 5, qb = u & 31, h = bh & 3, b = bh >> 2; const size_t r0 = (size_t)b * SEQ;
            att::attn_dense_body<0, 6, bf16_t>(MQ + (r0 + qb * 256) * 512 + h * 128, 512, MK + r0 * 512 + h * 128, 512, MV + r0 * 512 + h * 128, 512,
                                               A2 + (r0 + qb * 256) * 1024 + h * 128, 1024, SEQ, 0.10206207261596577f, lds, WV_, nullptr, 0, 0.f, nullptr, ZBUF + (r0 + qb * 256) * LDZ1 + Z1_CQ, LDZ1); } } SEAM(18);
    {
        chk::Cfg cf; cf.Z = ZBUF; cf.ld = LDZ1; cf.qcol = Z1_GQ; cf.kcol = Z1_GK; cf.vcol = Z1_GV; cf.gcol = Z1_GG; cf.BF = (const float*)(ws + WS_BF); cf.BB = (const float*)(ws + WS_BB);
        cf.dec_f = nullptr; cf.dec_b = nullptr; cf.qscale = 0.125f; cf.U = (bf16_t*)(ws + WS_U); cf.OUT = A2; cf.ldo = 1024; cf.ocol = 512; cf.gain = KARG(args, 19);
        if (IN(19)) { for (int u = vcu; u < 256; u += G) chk::chunk_states<64, false>(cf, lds, u, WV_); } SEAM(19);
        if (IN(20)) { if (tid < 256) chk::chunk_scan<64, false>(cf, bx * 256 + tid); } SEAM(20);
        if (IN(21)) { for (int u = vcu; u < 256; u += G) chk::chunk_out<64, false>(cf, lds, u, WV_); } SEAM(21);
    }
    if (IN(22)) { pg8::Gemm g{A2, (const bf16_t*)(ws + WS_WOUT1), 1024, 1024, 1024}; pg8::StaticOrder S; S.init(NTOK, 1024, G, bx);
        pg8::EpiBf16 E{(bf16_t*)Y, 1024, 0, 0}; pg8::gemm_phase<pg8::EpiBf16, pg8::StaticOrder, true>(ldsl, g, S, E, WV_); } SEAM(22);
    if (IN(23)) { p_ln1_router<false>(args, lds, vcu, G, 1, XB, WV_); } SEAM(23);
    if (IN(24)) { p_moe_scatter(args, lds, vcu, G, 1, WV_); } SEAM(24);
    if (IN(25)) { pg8::Gemm g{XB, (const bf16_t*)(ws + WS_WGU), 1024, 1024, 1024}; pg8::MoeOrder S{(const int*)(ws + WS_TILES), G, vcu, 1024};
        pg8::EpiGU E{(bf16_t*)(ws + WS_H), 512}; pg8::gemm_phase<pg8::EpiGU, pg8::MoeOrder, true, true>(ldsl, g, S, E, WV_, (const int2*)(ws + WS_ROWINFO)); } SEAM(25);
    if (IN(26)) { pg8::Gemm g{(const bf16_t*)(ws + WS_H), (const bf16_t*)(ws + WS_WDN), 512, 512, 512}; pg8::MoeOrder S{(const int*)(ws + WS_TILES), G, vcu, 1024};
        pg8::EpiDown E{(bf16_t*)(ws + WS_YS), (const int2*)(ws + WS_ROWINFO)}; pg8::gemm_phase<pg8::EpiDown, pg8::MoeOrder, true>(ldsl, g, S, E, WV_); } SEAM(26);
    if (IN(27)) { p_ln2<true>(args, vcu, G, 1, KOUT(args), WV_); }
#undef IN
#undef SEAM
#undef ws
#undef XB
#undef ZBUF
#undef A2
#undef X1F
#undef Y
}

#ifndef DBG_STOP
#define DBG_STOP -1
#endif
__global__ void dbg_dump(const void* src, int is_bf16, float* out, size_t n, int sanitize_only) {
    for (size_t i = (size_t)blockIdx.x * blockDim.x + threadIdx.x; i < n; i += (size_t)gridDim.x * blockDim.x) {
        float v = (sanitize_only == 1) ? out[i] : (is_bf16 ? bf1(((const bf16_t*)src)[i]) : ((const float*)src)[i]);
        if (!(fabsf(v) < 1e30f)) v = 777.f;
        if (sanitize_only == 2 && (i & 1023) >= 512) v = 0.f;
        if (sanitize_only == 3 && (i & 1023) < 512) v = 0.f;
        out[i] = v; }
}
#ifndef MK_SPLIT
#define MK_SPLIT 0
#endif
extern "C" void kernel_launch(void* const* d_in, const int* in_sizes, int n_in, void* d_out, int out_size, void* d_ws, size_t ws_size, hipStream_t stream) {
    static int grid = 0;
    if (grid == 0) {
        if (n_in != 32 || out_size != NTOK * DM || ws_size < WS_END) { fprintf(stderr, "kernel_launch: unexpected shapes (n_in %d, out %d, ws %zu < %zu)\n", n_in, out_size, ws_size, (size_t)WS_END); grid = -1; return; }
        int dev = 0, cus = 0, per_cu = 0;
        if (hipGetDevice(&dev) != hipSuccess || hipDeviceGetAttribute(&cus, hipDeviceAttributeMultiprocessorCount, dev) != hipSuccess) { grid = -1; return; }
        if (hipFuncSetAttribute((const void*)mega_fwd, hipFuncAttributeMaxDynamicSharedMemorySize, LDS_BYTES) != hipSuccess) { fprintf(stderr, "kernel_launch: hipFuncSetAttribute failed\n"); grid = -1; return; }
        if (hipOccupancyMaxActiveBlocksPerMultiprocessor(&per_cu, (const void*)mega_fwd, NWAVES * 64, LDS_BYTES) != hipSuccess || per_cu < 1)
            fprintf(stderr, "kernel_launch: occupancy query reports %d\n", per_cu);
        (void)hipGetLastError();
        grid = cus;
    }
    if (grid < 0) return;
    (void)hipMemsetAsync((char*)d_ws + WS_CTL, 0, CTL_ZERO_BYTES, stream);
    Args a{};
    for (int i = 0; i < 32; ++i) a.in[i] = (const float*)d_in[i];
    a.out = (float*)d_out; a.ws = (unsigned char*)d_ws;
#if MK_SPLIT
    const int plast = (DBG_STOP >= 0) ? DBG_STOP : NPHASE - 1;
    for (int p = 0; p <= plast; ++p) { a.ph_lo = p; a.ph_hi = p + 1; hipLaunchKernelGGL(mega_fwd, dim3(grid), dim3(NWAVES * 64), LDS_BYTES, stream, a); }
    if (DBG_STOP >= 0) {
        const void* srcp = nullptr; int isb = 0, sano = 0;
        switch (DBG_STOP) {
            case 1: case 2: srcp = (char*)d_ws + WS_Z; isb = 1; break;
            case 5: case 18: srcp = (char*)d_ws + WS_A2; isb = 1; sano = 2; break;
            case 7: case 21: srcp = (char*)d_ws + WS_A2; isb = 1; sano = 3; break;
            case 3: case 4: case 19: case 20: srcp = (char*)d_ws + WS_U; isb = 1; break;
            case 6: srcp = (char*)d_ws + WS_OAB; isb = 0; break;
            case 8: case 22: srcp = (char*)d_ws + WS_Y; isb = 0; break;
            case 9: case 23: srcp = (char*)d_ws + WS_X1F; isb = 0; break;
            case 12: case 26: srcp = (char*)d_ws + WS_YS; isb = 1; break;
            case 14: case 16: srcp = (char*)d_ws + WS_Z; isb = 1; break;
            default: sano = 1; break;
        }
        hipLaunchKernelGGL(dbg_dump, dim3(2048), dim3(256), 0, stream, srcp, isb, (float*)d_out, (size_t)NTOK * DM, sano);
    }
#else
#ifdef PROBE_REP
    a.ph_lo = 0; a.ph_hi = PROBE_REP_HI; hipLaunchKernelGGL(mega_fwd, dim3(grid), dim3(NWAVES * 64), LDS_BYTES, stream, a);
    if (PROBE_REP == 9 || PROBE_REP == 23) (void)hipMemsetAsync((char*)d_ws + WS_CTL + CW_CNT0 * 4, 0, 512, stream);
    for (int r = 0; r < PROBE_REP_N; ++r) for (int p = PROBE_REP; p < PROBE_REP_HI; ++p) { a.ph_lo = p; a.ph_hi = p + 1; hipLaunchKernelGGL(mega_fwd, dim3(grid), dim3(NWAVES * 64), LDS_BYTES, stream, a); }
    if (PROBE_REP_HI < NPHASE) { (void)hipMemsetAsync((char*)d_ws + WS_CTL + CW_BAR * 4, 0, XCD_BAR_WORDS * 4, stream); a.ph_lo = PROBE_REP_HI; a.ph_hi = NPHASE; hipLaunchKernelGGL(mega_fwd, dim3(grid), dim3(NWAVES * 64), LDS_BYTES, stream, a); }
#else
    a.ph_lo = 0; a.ph_hi = NPHASE; hipLaunchKernelGGL(mega_fwd, dim3(grid), dim3(NWAVES * 64), LDS_BYTES, stream, a);
#endif
#endif
}
```
